# Optimizing an MI355X kernel written in HIP

```python
import math
import jax, jax.numpy as jnp
from jax import lax
import numpy as np

D_MODEL = 1024
BATCH = 8
SEQ = 2048
DEPTH = 1

HEAD_DIM = 64
D_DIFF = D_MODEL // 2
D_DIL = D_MODEL - D_DIFF
DIFF_V_DIM = 2 * HEAD_DIM
N_HEADS_DIFF = D_DIFF // DIFF_V_DIM
N_HEADS_DIL = D_DIL // HEAD_DIM
D_MIX = D_DIFF + D_DIL
D_IN = 3 * D_DIFF + 3 * D_DIL
DIL_PATTERNS = ((128, 1), (512, 4), (2048, 16))
DIL_BLOCK = 64
Q_BLOCK = 128
D_FF = 4 * D_MODEL
D_PLE = 256
ROPE_THETA = 10000.0
NORM_EPS = 1e-6
SUBLN_EPS = 1e-5
NEG_INF = -1e30

kernel_name = "hybrid_diffattn_dilated_encoder_layer"


def rms_norm(x, g, eps=NORM_EPS):
    xf = x.astype(jnp.float32)
    y = xf * lax.rsqrt(jnp.mean(xf * xf, axis=-1, keepdims=True) + eps)
    return (y * g.astype(jnp.float32)).astype(x.dtype)


def rope_tables(seq):
    inv = ROPE_THETA ** (-jnp.arange(0, HEAD_DIM, 2, dtype=jnp.float32) / HEAD_DIM)
    ang = jnp.arange(seq, dtype=jnp.float32)[:, None] * inv[None, :]
    return jnp.cos(ang), jnp.sin(ang)


def apply_rope(t, cos, sin):
    t1, t2 = jnp.split(t.astype(jnp.float32), 2, axis=-1)
    out = jnp.concatenate([t1 * cos - t2 * sin, t1 * sin + t2 * cos], axis=-1)
    return out.astype(t.dtype)


def diff_attention(q, k, v, lam, subln_g, lam_init):
    B, H, _, S, Dh = q.shape
    nq = S // Q_BLOCK
    scale = Dh ** -0.5
    qb = q.reshape(B, H, 2, nq, Q_BLOCK, Dh).transpose(3, 0, 1, 2, 4, 5)
    kf = k.astype(jnp.float32)
    vf = v.astype(jnp.float32)

    def block(qblk):
        s = jnp.einsum('bhmqd,bhmkd->bhmqk', qblk.astype(jnp.float32) * scale, kf)
        pr = jax.nn.softmax(s, axis=-1)
        a = pr[:, :, 0] - lam * pr[:, :, 1]
        return jnp.einsum('bhqk,bhkd->bhqd', a, vf)

    o = lax.map(block, qb)
    o = o.transpose(1, 2, 0, 3, 4).reshape(B, H, S, 2 * Dh)
    o = rms_norm(o, subln_g, SUBLN_EPS) * (1.0 - lam_init)
    return o


def dilated_branch(q, k, v, dilation, radius):
    B, H, S, Dh = q.shape
    L = S // dilation

    def split(t):
        return t.reshape(B, H, L, dilation, Dh).transpose(0, 1, 3, 2, 4)

    qs, ks, vs = split(q), split(k), split(v)
    nb = -(-L // DIL_BLOCK)
    Lp = nb * DIL_BLOCK
    qb = jnp.pad(qs, ((0, 0), (0, 0), (0, 0), (0, Lp - L), (0, 0)))
    qb = qb.reshape(B, H, dilation, nb, DIL_BLOCK, Dh)

    def windows(t):
        tp = jnp.pad(t, ((0, 0), (0, 0), (0, 0), (DIL_BLOCK, Lp - L + DIL_BLOCK), (0, 0)))
        tb = tp.reshape(B, H, dilation, nb + 2, DIL_BLOCK, Dh)
        return jnp.concatenate([tb[:, :, :, :-2], tb[:, :, :, 1:-1], tb[:, :, :, 2:]], axis=-2)

    kw, vw = windows(ks), windows(vs)
    s = jnp.einsum('bhrnqd,bhrnkd->bhrnqk', qb.astype(jnp.float32),
                   kw.astype(jnp.float32)) * (Dh ** -0.5)
    a = jnp.arange(DIL_BLOCK)[:, None]
    c = jnp.arange(3 * DIL_BLOCK)[None, :]
    off = c - DIL_BLOCK - a
    kpos = (jnp.arange(nb)[:, None, None] - 1) * DIL_BLOCK + c[None]
    mask = (jnp.abs(off)[None] <= radius) & (kpos >= 0) & (kpos < L)
    s = jnp.where(mask, s, NEG_INF)
    lse = jax.nn.logsumexp(s, axis=-1)
    pr = jnp.exp(s - lse[..., None])
    o = jnp.einsum('bhrnqk,bhrnkd->bhrnqd', pr, vw.astype(jnp.float32))
    o = o.reshape(B, H, dilation, Lp, Dh)[:, :, :, :L]
    lse = lse.reshape(B, H, dilation, Lp)[:, :, :, :L]
    o = o.transpose(0, 1, 3, 2, 4).reshape(B, H, S, Dh)
    lse = lse.transpose(0, 1, 3, 2).reshape(B, H, S)
    return o, lse


def dilated_attention(q, k, v):
    outs, lses = [], []
    for window, dilation in DIL_PATTERNS:
        o, l = dilated_branch(q, k, v, dilation, window // (2 * dilation))
        outs.append(o)
        lses.append(l)
    w = jax.nn.softmax(jnp.stack(lses, axis=0), axis=0)
    return jnp.sum(w[..., None] * jnp.stack(outs, axis=0), axis=0)


def setup_inputs(seed: int = 0) -> dict:
    key = jax.random.key(seed)
    ks = jax.random.split(key, 20)
    f32 = jnp.float32
    nrm = lambda k, shape, s: jax.random.normal(k, shape, f32) * s
    gain = lambda k, shape: 1.0 + 0.05 * jax.random.normal(k, shape, f32)
    return {
        "x": jax.random.normal(ks[0], (BATCH, SEQ, D_MODEL), f32),
        "p": jax.random.normal(ks[1], (DEPTH, BATCH, SEQ, D_PLE), f32),
        "w_in": nrm(ks[2], (DEPTH, D_MODEL, D_IN), D_MODEL ** -0.5),
        "w_out": nrm(ks[3], (DEPTH, D_MIX, D_MODEL), D_MIX ** -0.5),
        "g_mix": gain(ks[4], (DEPTH, D_MODEL)),
        "lambda_q1": nrm(ks[5], (DEPTH, HEAD_DIM), 0.1),
        "lambda_k1": nrm(ks[6], (DEPTH, HEAD_DIM), 0.1),
        "lambda_q2": nrm(ks[7], (DEPTH, HEAD_DIM), 0.1),
        "lambda_k2": nrm(ks[8], (DEPTH, HEAD_DIM), 0.1),
        "g_subln": gain(ks[9], (DEPTH, DIFF_V_DIM)),
        "g_mlp": gain(ks[10], (DEPTH, D_MODEL)),
        "w_up": nrm(ks[11], (DEPTH, D_MODEL, D_FF), D_MODEL ** -0.5),
        "w_down": nrm(ks[12], (DEPTH, D_FF, D_MODEL), 0.5 * D_FF ** -0.5),
        "g_ple": gain(ks[13], (DEPTH, D_MODEL)),
        "w_ple_gate": nrm(ks[14], (DEPTH, D_MODEL, D_MODEL), D_MODEL ** -0.5),
        "w_ple_proj": nrm(ks[15], (DEPTH, D_PLE, D_MODEL), D_PLE ** -0.5),
        "g_final": gain(ks[16], (D_MODEL,)),
    }


def reference(x, p, w_in, w_out, g_mix, lambda_q1, lambda_k1, lambda_q2, lambda_k2, g_subln,
              g_mlp, w_up, w_down, g_ple, w_ple_gate, w_ple_proj, g_final):
    B, S, _ = x.shape
    cos, sin = rope_tables(S)
    splits = [D_DIFF, 2 * D_DIFF, 3 * D_DIFF, 3 * D_DIFF + D_DIL, 3 * D_DIFF + 2 * D_DIL]
    h = x
    for i in range(DEPTH):
        hn = rms_norm(h, g_mix[i])
        proj = hn @ w_in[i]
        qd, kd, vd, qg, kg, vg = jnp.split(proj, splits, axis=-1)

        qd = apply_rope(qd.reshape(B, S, N_HEADS_DIFF, 2, HEAD_DIM).transpose(0, 2, 3, 1, 4), cos, sin)
        kd = apply_rope(kd.reshape(B, S, N_HEADS_DIFF, 2, HEAD_DIM).transpose(0, 2, 3, 1, 4), cos, sin)
        vd = vd.reshape(B, S, N_HEADS_DIFF, DIFF_V_DIM).transpose(0, 2, 1, 3)
        lam_init = 0.8 - 0.6 * math.exp(-0.3 * i)
        lam = (jnp.exp(jnp.sum(lambda_q1[i].astype(jnp.float32) * lambda_k1[i].astype(jnp.float32)))
               - jnp.exp(jnp.sum(lambda_q2[i].astype(jnp.float32) * lambda_k2[i].astype(jnp.float32)))
               + lam_init)
        od = diff_attention(qd, kd, vd, lam, g_subln[i], lam_init)
        od = od.transpose(0, 2, 1, 3).reshape(B, S, D_DIFF)

        qg = apply_rope(qg.reshape(B, S, N_HEADS_DIL, HEAD_DIM).transpose(0, 2, 1, 3), cos, sin)
        kg = apply_rope(kg.reshape(B, S, N_HEADS_DIL, HEAD_DIM).transpose(0, 2, 1, 3), cos, sin)
        vg = vg.reshape(B, S, N_HEADS_DIL, HEAD_DIM).transpose(0, 2, 1, 3)
        og = dilated_attention(qg, kg, vg)
        og = og.transpose(0, 2, 1, 3).reshape(B, S, D_DIL)

        mixed = jnp.concatenate([od, og], axis=-1).astype(h.dtype)
        h = h + mixed @ w_out[i]

        hn = rms_norm(h, g_mlp[i])
        h = h + jnp.square(jax.nn.relu(hn @ w_up[i])) @ w_down[i]

        gate = jax.nn.sigmoid(rms_norm(h, g_ple[i]) @ w_ple_gate[i])
        h = h + gate * (p[i] @ w_ple_proj[i])
    return rms_norm(h, g_final)
```

```cpp
#include <hip/hip_runtime.h>
#include <cstdint>
#include <cstdio>

namespace nv {
constexpr int DM = 1024, BATCH = 8, SEQ = 2048, M = BATCH * SEQ, DIN = 3072, DFF = 4096, DPLE = 256;
constexpr float NORM_EPS = 1e-6f, SUBLN_EPS = 1e-5f, LAM_INIT = 0.2f;

__device__ const double INV_FREQ[32] = {
    1.00000000000000000000e+00, 7.49894209332455874417e-01, 5.62341325190349072827e-01, 4.21696503428582225581e-01,
    3.16227766016837941176e-01, 2.37137370566165517349e-01, 1.77827941003892292526e-01, 1.33352143216332402753e-01,
    1.00000000000000005551e-01, 7.49894209332455791150e-02, 5.62341325190349114460e-02, 4.21696503428582239459e-02,
    3.16227766016837913421e-02, 2.37137370566165538166e-02, 1.77827941003892292526e-02, 1.33352143216332406223e-02,
    1.00000000000000002082e-02, 7.49894209332455791150e-03, 5.62341325190349097113e-03, 4.21696503428582291501e-03,
    3.16227766016837939442e-03, 2.37137370566165538166e-03, 1.77827941003892275179e-03, 1.33352143216332406223e-03,
    1.00000000000000002082e-03, 7.49894209332455856203e-04, 5.62341325190349097113e-04, 4.21696503428582237290e-04,
    3.16227766016837939442e-04, 2.37137370566165538166e-04, 1.77827941003892269758e-04, 1.33352143216332395381e-04};

__device__ __forceinline__ void rope_cs(int s, int j, float& c, float& sn) {
    const double ang = (double)s * INV_FREQ[j];
    double rev = ang * 0.15915494309189533577;
    rev -= floor(rev);
    const double q = rint(rev * 4.0);
    const double y = (rev - q * 0.25) * 6.28318530717958647692;
    const double y2 = y * y;
    const double sy = y * (1.0 + y2 * (-1.0 / 6 + y2 * (1.0 / 120 + y2 * (-1.0 / 5040 + y2 * (1.0 / 362880 + y2 * (-1.0 / 39916800 + y2 * (1.0 / 6227020800.0)))))));
    const double cy = 1.0 + y2 * (-0.5 + y2 * (1.0 / 24 + y2 * (-1.0 / 720 + y2 * (1.0 / 40320 + y2 * (-1.0 / 3628800 + y2 * (1.0 / 479001600 + y2 * (-1.0 / 87178291200.0)))))));
    const int qi = ((int)q) & 3;
    double cc, ss;
    if (qi == 0) { cc = cy; ss = sy; } else if (qi == 1) { cc = -sy; ss = cy; } else if (qi == 2) { cc = -cy; ss = -sy; } else { cc = sy; ss = -cy; }
    c = (float)cc; sn = (float)ss;
}

__global__ void k_setup(float* cs, float* lamp, const float* lq1, const float* lk1, const float* lq2, const float* lk2) {
    const int idx = blockIdx.x * blockDim.x + threadIdx.x;
    if (idx < SEQ * 32) { float c, s; rope_cs(idx >> 5, idx & 31, c, s); cs[2 * idx] = c; cs[2 * idx + 1] = s; }
    if (idx == 0) { float a = 0.f, b = 0.f; for (int i = 0; i < 64; ++i) { a += lq1[i] * lk1[i]; b += lq2[i] * lk2[i]; } lamp[0] = expf(a) - expf(b) + LAM_INIT; }
}

__device__ __forceinline__ float wave_sum(float v) {
#pragma unroll
    for (int o = 1; o < 64; o <<= 1) v += __shfl_xor(v, o);
    return v;
}
__device__ __forceinline__ float wave_max(float v) {
#pragma unroll
    for (int o = 1; o < 64; o <<= 1) v = fmaxf(v, __shfl_xor(v, o));
    return v;
}

__global__ void k_rmsnorm(const float* x, const float* g, float* out) {
    const int row = blockIdx.x * 4 + (threadIdx.x >> 6), lane = threadIdx.x & 63;
    const float4* xr = (const float4*)(x + (size_t)row * DM) + lane;
    float4 v[4]; float s = 0.f;
#pragma unroll
    for (int j = 0; j < 4; ++j) { v[j] = xr[64 * j]; s += v[j].x * v[j].x + v[j].y * v[j].y + v[j].z * v[j].z + v[j].w * v[j].w; }
    const float r = 1.0f / sqrtf(wave_sum(s) * (1.f / DM) + NORM_EPS);
    float4* o = (float4*)(out + (size_t)row * DM) + lane;
#pragma unroll
    for (int j = 0; j < 4; ++j) { const float4 gg = ((const float4*)g)[lane + 64 * j]; o[64 * j] = make_float4(v[j].x * r * gg.x, v[j].y * r * gg.y, v[j].z * r * gg.z, v[j].w * r * gg.w); }
}

template <int EPI>
__global__ __launch_bounds__(256) void k_gemm(const float* A, int lda, const float* B, int ldb, float* C, int ldc, int K) {
    __shared__ float As[16][65];
    __shared__ float Bs[16][64];
    const int t = threadIdx.x, tx = t & 15, ty = t >> 4;
    const int m0 = blockIdx.y * 64, n0 = blockIdx.x * 64;
    float acc[4][4];
#pragma unroll
    for (int i = 0; i < 4; ++i)
#pragma unroll
        for (int j = 0; j < 4; ++j) acc[i][j] = 0.f;
    for (int k0 = 0; k0 < K; k0 += 16) {
        { const int r = t >> 2, kq = (t & 3) * 4; const float4 v = *(const float4*)(A + (size_t)(m0 + r) * lda + k0 + kq);
          As[kq + 0][r] = v.x; As[kq + 1][r] = v.y; As[kq + 2][r] = v.z; As[kq + 3][r] = v.w; }
        { const int k = t >> 4, nq = (t & 15) * 4; *(float4*)&Bs[k][nq] = *(const float4*)(B + (size_t)(k0 + k) * ldb + n0 + nq); }
        __syncthreads();
#pragma unroll
        for (int k = 0; k < 16; ++k) {
            float a[4], b[4];
#pragma unroll
            for (int i = 0; i < 4; ++i) a[i] = As[k][ty * 4 + i];
#pragma unroll
            for (int j = 0; j < 4; ++j) b[j] = Bs[k][tx * 4 + j];
#pragma unroll
            for (int i = 0; i < 4; ++i)
#pragma unroll
                for (int j = 0; j < 4; ++j) acc[i][j] += a[i] * b[j];
        }
        __syncthreads();
    }
#pragma unroll
    for (int i = 0; i < 4; ++i) {
        float4* cp = (float4*)(C + (size_t)(m0 + ty * 4 + i) * ldc + n0 + tx * 4);
        float4 v = make_float4(acc[i][0], acc[i][1], acc[i][2], acc[i][3]);
        if (EPI == 1) { const float4 o = *cp; v.x += o.x; v.y += o.y; v.z += o.z; v.w += o.w; }
        if (EPI == 2) { v.x = fmaxf(v.x, 0.f); v.y = fmaxf(v.y, 0.f); v.z = fmaxf(v.z, 0.f); v.w = fmaxf(v.w, 0.f); v.x *= v.x; v.y *= v.y; v.z *= v.z; v.w *= v.w; }
        *cp = v;
    }
}

__global__ void k_rope(float* proj, const float* cs) {
    const size_t idx = (size_t)blockIdx.x * blockDim.x + threadIdx.x;
    const int j = idx & 31, ch = (idx >> 5) & 31; const size_t tok = idx >> 10;
    const int s = (int)(tok % SEQ);
    const int col = (ch < 16 ? ch * 64 : 1536 + (ch - 16) * 64);
    float* p = proj + tok * DIN + col;
    const float c = cs[2 * (s * 32 + j)], sn = cs[2 * (s * 32 + j) + 1];
    const float t1 = p[j], t2 = p[j + 32];
    p[j] = t1 * c - t2 * sn; p[j + 32] = t1 * sn + t2 * c;
}

__global__ __launch_bounds__(256) void k_diff(const float* proj, const float* lamp, const float* gsub, float* mixed) {
    __shared__ float q1[64], q2[64], a[SEQ], red[8], o2[128];
    const int t = threadIdx.x, lane = t & 63, w = t >> 6;
    const int qi = blockIdx.x % SEQ, h = (blockIdx.x / SEQ) & 3, b = blockIdx.x / (SEQ * 4);
    const float* base = proj + (size_t)b * SEQ * DIN;
    if (t < 64) q1[t] = base[(size_t)qi * DIN + h * 128 + t] * 0.125f; else if (t < 128) q2[t - 64] = base[(size_t)qi * DIN + h * 128 + t] * 0.125f;
    __syncthreads();
    float s1[8], s2[8]; float m1 = -1e30f, m2 = -1e30f;
#pragma unroll
    for (int i = 0; i < 8; ++i) {
        const int k = t + 256 * i; const float4* kr = (const float4*)(base + (size_t)k * DIN + 512 + h * 128);
        float d1 = 0.f, d2 = 0.f;
#pragma unroll
        for (int d = 0; d < 16; ++d) { const float4 kv = kr[d]; d1 += q1[4 * d] * kv.x + q1[4 * d + 1] * kv.y + q1[4 * d + 2] * kv.z + q1[4 * d + 3] * kv.w; }
#pragma unroll
        for (int d = 0; d < 16; ++d) { const float4 kv = kr[16 + d]; d2 += q2[4 * d] * kv.x + q2[4 * d + 1] * kv.y + q2[4 * d + 2] * kv.z + q2[4 * d + 3] * kv.w; }
        s1[i] = d1; s2[i] = d2; m1 = fmaxf(m1, d1); m2 = fmaxf(m2, d2);
    }
    m1 = wave_max(m1); m2 = wave_max(m2);
    if (lane == 0) { red[w] = m1; red[4 + w] = m2; }
    __syncthreads();
    m1 = fmaxf(fmaxf(red[0], red[1]), fmaxf(red[2], red[3])); m2 = fmaxf(fmaxf(red[4], red[5]), fmaxf(red[6], red[7]));
    __syncthreads();
    float l1 = 0.f, l2 = 0.f;
#pragma unroll
    for (int i = 0; i < 8; ++i) { s1[i] = expf(s1[i] - m1); s2[i] = expf(s2[i] - m2); l1 += s1[i]; l2 += s2[i]; }
    l1 = wave_sum(l1); l2 = wave_sum(l2);
    if (lane == 0) { red[w] = l1; red[4 + w] = l2; }
    __syncthreads();
    l1 = (red[0] + red[1]) + (red[2] + red[3]); l2 = (red[4] + red[5]) + (red[6] + red[7]);
    const float lam = lamp[0];
#pragma unroll
    for (int i = 0; i < 8; ++i) a[t + 256 * i] = s1[i] / l1 - lam * (s2[i] / l2);
    __syncthreads();
    const int d = t & 127, hf = t >> 7;
    const float* vb = base + 1024 + h * 128 + d;
    float o = 0.f;
    for (int k = hf * 1024; k < hf * 1024 + 1024; ++k) o += a[k] * vb[(size_t)k * DIN];
    if (hf == 1) o2[d] = o;
    __syncthreads();
    if (hf == 0) o += o2[d];
    float sq = (hf == 0) ? o * o : 0.f;
    sq = wave_sum(sq);
    __syncthreads();
    if (lane == 0) red[w] = sq;
    __syncthreads();
    const float ms = (red[0] + red[1]) * (1.f / 128.f);
    if (hf == 0) mixed[((size_t)b * SEQ + qi) * DM + h * 128 + d] = o * (1.0f / sqrtf(ms + SUBLN_EPS)) * gsub[d] * (1.0f - LAM_INIT);
}

__global__ __launch_bounds__(256) void k_dil(const float* proj, float* mixed) {
    __shared__ float pbuf[4][192];
    const int lane = threadIdx.x & 63, w = threadIdx.x >> 6;
    const int gw = blockIdx.x * 4 + w;
    const int h = gw & 7, s = (gw >> 3) % SEQ, b = gw / (8 * SEQ);
    const float* base = proj + (size_t)b * SEQ * DIN;
    const float* qp = base + (size_t)s * DIN + 1536 + h * 64;
    float q[64];
#pragma unroll
    for (int d = 0; d < 16; ++d) { const float4 v = ((const float4*)qp)[d]; q[4 * d] = v.x; q[4 * d + 1] = v.y; q[4 * d + 2] = v.z; q[4 * d + 3] = v.w; }
    float outs[3], lses[3];
#pragma unroll
    for (int pi = 0; pi < 3; ++pi) {
        const int dil = (pi == 0) ? 1 : (pi == 1) ? 4 : 16;
        float sc[3]; float mx = -1e30f;
#pragma unroll
        for (int i = 0; i < 3; ++i) {
            const int j = lane + 64 * i;
            const int kp = s + (j - 64) * dil;
            float dsum = -1e30f;
            if (j <= 128 && kp >= 0 && kp < SEQ) {
                const float4* kr = (const float4*)(base + (size_t)kp * DIN + 2048 + h * 64);
                float acc = 0.f;
#pragma unroll
                for (int d = 0; d < 16; ++d) { const float4 kv = kr[d]; acc += q[4 * d] * kv.x + q[4 * d + 1] * kv.y + q[4 * d + 2] * kv.z + q[4 * d + 3] * kv.w; }
                dsum = acc * 0.125f;
            }
            sc[i] = dsum; mx = fmaxf(mx, dsum);
        }
        mx = wave_max(mx);
        float l = 0.f;
#pragma unroll
        for (int i = 0; i < 3; ++i) { const float e = (sc[i] > -1e29f) ? expf(sc[i] - mx) : 0.f; sc[i] = e; l += e; }
        l = wave_sum(l);
        __syncthreads();
#pragma unroll
        for (int i = 0; i < 3; ++i) pbuf[w][lane + 64 * i] = sc[i] / l;
        __syncthreads();
        float o = 0.f;
        for (int j = 0; j <= 128; ++j) { const int kp = s + (j - 64) * dil; if (kp >= 0 && kp < SEQ) o += pbuf[w][j] * base[(size_t)kp * DIN + 2560 + h * 64 + lane]; }
        outs[pi] = o; lses[pi] = mx + logf(l);
    }
    const float mm = fmaxf(lses[0], fmaxf(lses[1], lses[2]));
    const float w0 = expf(lses[0] - mm), w1 = expf(lses[1] - mm), w2 = expf(lses[2] - mm);
    mixed[((size_t)b * SEQ + s) * DM + 512 + h * 64 + lane] = (w0 * outs[0] + w1 * outs[1] + w2 * outs[2]) / (w0 + w1 + w2);
}

__global__ void k_ple(float* h, const float* gate, const float* pp) {
    const size_t i = (size_t)blockIdx.x * blockDim.x + threadIdx.x;
    const float4 g = ((const float4*)gate)[i], p = ((const float4*)pp)[i]; float4 v = ((float4*)h)[i];
    v.x += p.x / (1.f + expf(-g.x)); v.y += p.y / (1.f + expf(-g.y)); v.z += p.z / (1.f + expf(-g.z)); v.w += p.w / (1.f + expf(-g.w));
    ((float4*)h)[i] = v;
}
}

extern "C" void kernel_launch(void* const* d_in, const int* in_sizes, int n_in, void* d_out, int out_size, void* d_ws, size_t ws_size, hipStream_t stream) {
    using namespace nv;
    const float* x = (const float*)d_in[0]; const float* p = (const float*)d_in[1]; const float* w_in = (const float*)d_in[2]; const float* w_out = (const float*)d_in[3];
    const float* g_mix = (const float*)d_in[4]; const float* lq1 = (const float*)d_in[5]; const float* lk1 = (const float*)d_in[6]; const float* lq2 = (const float*)d_in[7];
    const float* lk2 = (const float*)d_in[8]; const float* g_subln = (const float*)d_in[9]; const float* g_mlp = (const float*)d_in[10]; const float* w_up = (const float*)d_in[11];
    const float* w_down = (const float*)d_in[12]; const float* g_ple = (const float*)d_in[13]; const float* w_gate = (const float*)d_in[14]; const float* w_pp = (const float*)d_in[15];
    const float* g_final = (const float*)d_in[16];
    float* out = (float*)d_out; float* ws = (float*)d_ws;
    const size_t MiBf = (1u << 20) / 4;
    float* proj = ws; float* mixed = ws + 192 * MiBf;
    float* cs = out; float* lamp = out + SEQ * 64;
    hipLaunchKernelGGL(k_setup, dim3(SEQ * 32 / 256), dim3(256), 0, stream, cs, lamp, lq1, lk1, lq2, lk2);
    hipLaunchKernelGGL(k_rmsnorm, dim3(M / 4), dim3(256), 0, stream, x, g_mix, mixed);
    hipLaunchKernelGGL(k_gemm<0>, dim3(DIN / 64, M / 64), dim3(256), 0, stream, (const float*)mixed, DM, w_in, DIN, proj, DIN, DM);
    hipLaunchKernelGGL(k_rope, dim3((unsigned)((size_t)M * 1024 / 256)), dim3(256), 0, stream, proj, (const float*)cs);
    hipLaunchKernelGGL(k_diff, dim3(BATCH * 4 * SEQ), dim3(256), 0, stream, (const float*)proj, (const float*)lamp, g_subln, mixed);
    hipLaunchKernelGGL(k_dil, dim3(M * 8 / 4), dim3(256), 0, stream, (const float*)proj, mixed);
    hipMemcpyAsync(out, x, (size_t)M * DM * 4, hipMemcpyDeviceToDevice, stream);
    hipLaunchKernelGGL(k_gemm<1>, dim3(DM / 64, M / 64), dim3(256), 0, stream, (const float*)mixed, DM, w_out, DM, out, DM, DM);
    float* hn = ws; float* u = ws + 64 * MiBf; float* pp = ws + 128 * MiBf;
    hipLaunchKernelGGL(k_rmsnorm, dim3(M / 4), dim3(256), 0, stream, (const float*)out, g_mlp, hn);
    for (int c = 0; c < 4; ++c) {
        hipLaunchKernelGGL(k_gemm<2>, dim3(1024 / 64, M / 64), dim3(256), 0, stream, (const float*)hn, DM, w_up + c * 1024, DFF, u, 1024, DM);
        hipLaunchKernelGGL(k_gemm<1>, dim3(DM / 64, M / 64), dim3(256), 0, stream, (const float*)u, 1024, w_down + (size_t)c * 1024 * DM, DM, out, DM, 1024);
    }
    hipLaunchKernelGGL(k_rmsnorm, dim3(M / 4), dim3(256), 0, stream, (const float*)out, g_ple, hn);
    hipLaunchKernelGGL(k_gemm<0>, dim3(DM / 64, M / 64), dim3(256), 0, stream, (const float*)hn, DM, w_gate, DM, u, DM, DM);
    hipLaunchKernelGGL(k_gemm<0>, dim3(DM / 64, M / 64), dim3(256), 0, stream, p, DPLE, w_pp, DM, pp, DM, DPLE);
    hipLaunchKernelGGL(k_ple, dim3((unsigned)((size_t)M * DM / 4 / 256)), dim3(256), 0, stream, out, (const float*)u, (const float*)pp);
    hipLaunchKernelGGL(k_rmsnorm, dim3(M / 4), dim3(256), 0, stream, (const float*)out, g_final, out);
}
```

```cpp
#include <hip/hip_runtime.h>
#include <cstdio>
#include <cstdint>
namespace pg8 {
#define PG8_LAS __attribute__((address_space(3)))
typedef unsigned short bf16_t;
typedef short bf16x8 __attribute__((ext_vector_type(8)));
typedef float f32x4 __attribute__((ext_vector_type(4)));
typedef unsigned u32x4 __attribute__((ext_vector_type(4)));
constexpr int BM = 256, BK = 64, HALF = 128, HTB = HALF * BK * 2  , STAGE_BYTES = 8 * HTB, NXCD = 8, WGM = 8;

__host__ __device__ __forceinline__ int lds_byte(int r, int c) { const int st = (r >> 4) * 2 + (c >> 5), rr = r & 15, cc = c & 31, ob = rr * 64 + cc * 2; return st * 1024 + (ob ^ (((ob >> 9) & 1) << 5)); }
__host__ __device__ __forceinline__ void stage_rc(int b, int& R, int& C) { const int st = b / 1024, sb = b % 1024, swz = sb ^ (((sb >> 9) & 1) << 5); R = (st >> 1) * 16 + swz / 64; C = (st & 1) * 32 + (swz % 64) / 2; }
__host__ __device__ __forceinline__ int perm32(int rho) { const int n = rho >> 4, i = rho & 15; return 8 * (i >> 2) + 4 * n + (i & 3); }

struct Unit { int pm, pn; };
struct Gemm { const bf16_t* A; const bf16_t* Bt; int M, N, K; };

struct StaticOrder {
    int nM, nN, nwg, G, c;
    __host__ __device__ void init(int M, int N, int G_, int c_) { nM = M / BM; nN = N / BM; nwg = nM * nN; G = G_; c = c_; }
    __host__ __device__ bool next(int i, Unit& u) const {
        const long L = (long)i * G + c; if (L >= nwg) return false;
        int wgid = (int)L; { const int q = nwg / NXCD, r = nwg % NXCD, xcd = wgid % NXCD, off = wgid / NXCD; wgid = (xcd < r ? xcd * (q + 1) : r * (q + 1) + (xcd - r) * q) + off; }
        const int nig = WGM * nN, gid = wgid / nig, fm = gid * WGM, gsz = (nM - fm) < WGM ? (nM - fm) : WGM;
        u.pm = fm + ((wgid % nig) % gsz); u.pn = (wgid % nig) / gsz; return true;
    }
    __device__ __forceinline__ void a_ready(const Unit&) const {}
    __device__ __forceinline__ void done(const Unit&) const {}
};


__device__ __forceinline__ unsigned cvt_pk_bf16(float lo, float hi) { unsigned r; asm volatile("v_cvt_pk_bf16_f32 %0, %1, %2" : "=v"(r) : "v"(lo), "v"(hi)); return r; }
__device__ __forceinline__ u32x4 pack8(const f32x4 a, const f32x4 b) { u32x4 w; w.x = cvt_pk_bf16(a[0], a[1]); w.y = cvt_pk_bf16(a[2], a[3]); w.z = cvt_pk_bf16(b[0], b[1]); w.w = cvt_pk_bf16(b[2], b[3]); return w; }
__device__ __forceinline__ float ssq16(const float* p) {
    const f32x4 a = ((const f32x4*)p)[0], b = ((const f32x4*)p)[1], c = ((const f32x4*)p)[2], d = ((const f32x4*)p)[3];
    return (((a[0] + a[1]) + (a[2] + a[3])) + ((b[0] + b[1]) + (b[2] + b[3]))) + (((c[0] + c[1]) + (c[2] + c[3])) + ((d[0] + d[1]) + (d[2] + d[3])));
}

struct EpiQKV {
    static constexpr bool PERM = true, AFTER_DRAIN = false;
    bf16_t* O; const float* cs; float qscale;
    __device__ __forceinline__ void operator()(const f32x4 (&acc)[2][2][4][2], const Unit& u, int wr, int wc, int fr, int fq) const {
        const int type = u.pn >> 1;
        const bool rope = (type != 2) && (type != 5);
        const float sc = (type == 0 || type == 3) ? qscale : 1.f;
        const int row0 = u.pm * BM + wr * 64 + fr, col0 = u.pn * BM + wc * 32 + 8 * fq, j0 = 16 * (wc & 1) + 4 * fq;
#pragma unroll
        for (int ai = 0; ai < 2; ++ai)
#pragma unroll
            for (int m = 0; m < 4; ++m) {
                const int row = row0 + ai * HALF + m * 16;
                f32x4 cA = (f32x4){1.f, 0.f, 1.f, 0.f}, cB = (f32x4){1.f, 0.f, 1.f, 0.f};
                if (rope) { const float* t = cs + ((row & 2047) * 32 + j0) * 2; cA = *(const f32x4*)t; cB = *(const f32x4*)(t + 4); }
                bf16_t* rowp = O + (size_t)row * 3072 + col0;
#pragma unroll
                for (int bj = 0; bj < 2; ++bj) {
                    const f32x4 v0 = acc[ai][bj][m][0], v1 = acc[ai][bj][m][1];
                    f32x4 o0, o1;
                    o0[0] = (v0[0] * cA[0] - v1[0] * cA[1]) * sc; o1[0] = (v0[0] * cA[1] + v1[0] * cA[0]) * sc;
                    o0[1] = (v0[1] * cA[2] - v1[1] * cA[3]) * sc; o1[1] = (v0[1] * cA[3] + v1[1] * cA[2]) * sc;
                    o0[2] = (v0[2] * cB[0] - v1[2] * cB[1]) * sc; o1[2] = (v0[2] * cB[1] + v1[2] * cB[0]) * sc;
                    o0[3] = (v0[3] * cB[2] - v1[3] * cB[3]) * sc; o1[3] = (v0[3] * cB[3] + v1[3] * cB[2]) * sc;
                    *(u32x4*)(rowp + bj * HALF) = pack8(o0, o1);
                }
            }
    }
};

struct EpiRes {
    static constexpr bool PERM = true, AFTER_DRAIN = false;
    const float* base; float* out; bf16_t* ob; float* ssq;
    __device__ __forceinline__ void operator()(const f32x4 (&acc)[2][2][4][2], const Unit& u, int wr, int wc, int fr, int fq) const {
        const int row0 = u.pm * BM + wr * 64 + fr, col0 = u.pn * BM + wc * 32 + 8 * fq;
#pragma unroll
        for (int ai = 0; ai < 2; ++ai)
#pragma unroll
            for (int m = 0; m < 4; ++m) {
                const int row = row0 + ai * HALF + m * 16; const size_t off = (size_t)row * 1024 + col0; float sq = 0.f;
#pragma unroll
                for (int bj = 0; bj < 2; ++bj) {
                    const f32x4 b0 = *(const f32x4*)(base + off + bj * HALF), b1 = *(const f32x4*)(base + off + bj * HALF + 4);
                    const f32x4 h0 = acc[ai][bj][m][0] + b0, h1 = acc[ai][bj][m][1] + b1;
                    *(f32x4*)(out + off + bj * HALF) = h0; *(f32x4*)(out + off + bj * HALF + 4) = h1;
                    *(u32x4*)(ob + off + bj * HALF) = pack8(h0, h1);
                    sq += ((h0[0] * h0[0] + h0[1] * h0[1]) + (h0[2] * h0[2] + h0[3] * h0[3])) + ((h1[0] * h1[0] + h1[1] * h1[1]) + (h1[2] * h1[2] + h1[3] * h1[3]));
                }
                sq += __shfl_xor(sq, 16); sq += __shfl_xor(sq, 32);
                if (fq == 0) ssq[(size_t)row * 16 + u.pn * 4 + wc] = sq;
            }
    }
};

struct EpiUp {
    static constexpr bool PERM = true, AFTER_DRAIN = false;
    bf16_t* O; const float* ssq; float eps;
    __device__ __forceinline__ void operator()(const f32x4 (&acc)[2][2][4][2], const Unit& u, int wr, int wc, int fr, int fq) const {
        const int row0 = u.pm * BM + wr * 64 + fr, col0 = u.pn * BM + wc * 32 + 8 * fq;
#pragma unroll
        for (int ai = 0; ai < 2; ++ai)
#pragma unroll
            for (int m = 0; m < 4; ++m) {
                const int row = row0 + ai * HALF + m * 16;
                const float rinv = 1.0f / sqrtf(ssq16(ssq + (size_t)row * 16) * (1.0f / 1024.0f) + eps);
                bf16_t* rowp = O + (size_t)row * 4096 + col0;
#pragma unroll
                for (int bj = 0; bj < 2; ++bj) {
                    f32x4 v0 = acc[ai][bj][m][0] * rinv, v1 = acc[ai][bj][m][1] * rinv;
#pragma unroll
                    for (int e = 0; e < 4; ++e) { const float a = fmaxf(v0[e], 0.f), b = fmaxf(v1[e], 0.f); v0[e] = a * a; v1[e] = b * b; }
                    *(u32x4*)(rowp + bj * HALF) = pack8(v0, v1);
                }
            }
    }
};

struct EpiStore {
    static constexpr bool PERM = true, AFTER_DRAIN = false;
    bf16_t* O;
    __device__ __forceinline__ void operator()(const f32x4 (&acc)[2][2][4][2], const Unit& u, int wr, int wc, int fr, int fq) const {
        const int row0 = u.pm * BM + wr * 64 + fr, col0 = u.pn * BM + wc * 32 + 8 * fq;
#pragma unroll
        for (int ai = 0; ai < 2; ++ai)
#pragma unroll
            for (int m = 0; m < 4; ++m) { bf16_t* rowp = O + (size_t)(row0 + ai * HALF + m * 16) * 1024 + col0;
#pragma unroll
                for (int bj = 0; bj < 2; ++bj) *(u32x4*)(rowp + bj * HALF) = pack8(acc[ai][bj][m][0], acc[ai][bj][m][1]); }
    }
};

struct EpiGate {
    static constexpr bool PERM = true, AFTER_DRAIN = false;
    const float* h; float* out; const bf16_t* pp; const float* ssq_in; float* ssq_out; float eps;
    __device__ __forceinline__ void operator()(const f32x4 (&acc)[2][2][4][2], const Unit& u, int wr, int wc, int fr, int fq) const {
        const int row0 = u.pm * BM + wr * 64 + fr, col0 = u.pn * BM + wc * 32 + 8 * fq;
#pragma unroll
        for (int ai = 0; ai < 2; ++ai)
#pragma unroll
            for (int m = 0; m < 4; ++m) {
                const int row = row0 + ai * HALF + m * 16; const size_t off = (size_t)row * 1024 + col0; float sq = 0.f;
                const float rinv = 1.0f / sqrtf(ssq16(ssq_in + (size_t)row * 16) * (1.0f / 1024.0f) + eps);
#pragma unroll
                for (int bj = 0; bj < 2; ++bj) {
                    const u32x4 pw = *(const u32x4*)(pp + off + bj * HALF);
                    const f32x4 b0 = *(const f32x4*)(h + off + bj * HALF), b1 = *(const f32x4*)(h + off + bj * HALF + 4);
                    const f32x4 g0 = acc[ai][bj][m][0] * (rinv * -1.4426950408889634f), g1 = acc[ai][bj][m][1] * (rinv * -1.4426950408889634f);
                    f32x4 p0, p1;
                    p0[0] = __uint_as_float(pw.x << 16); p0[1] = __uint_as_float(pw.x & 0xffff0000u); p0[2] = __uint_as_float(pw.y << 16); p0[3] = __uint_as_float(pw.y & 0xffff0000u);
                    p1[0] = __uint_as_float(pw.z << 16); p1[1] = __uint_as_float(pw.z & 0xffff0000u); p1[2] = __uint_as_float(pw.w << 16); p1[3] = __uint_as_float(pw.w & 0xffff0000u);
                    f32x4 h0, h1;
#pragma unroll
                    for (int e = 0; e < 4; ++e) {
                        h0[e] = b0[e] + p0[e] * __builtin_amdgcn_rcpf(1.0f + __builtin_amdgcn_exp2f(g0[e]));
                        h1[e] = b1[e] + p1[e] * __builtin_amdgcn_rcpf(1.0f + __builtin_amdgcn_exp2f(g1[e]));
                    }
                    *(f32x4*)(out + off + bj * HALF) = h0; *(f32x4*)(out + off + bj * HALF + 4) = h1;
                    sq += ((h0[0] * h0[0] + h0[1] * h0[1]) + (h0[2] * h0[2] + h0[3] * h0[3])) + ((h1[0] * h1[0] + h1[1] * h1[1]) + (h1[2] * h1[2] + h1[3] * h1[3]));
                }
                sq += __shfl_xor(sq, 16); sq += __shfl_xor(sq, 32);
                if (fq == 0) ssq_out[(size_t)row * 16 + u.pn * 4 + wc] = sq;
            }
    }
};
template <class Epi, class Sched, bool ALIGN_EPI = false, bool SP2 = false>
__device__ __forceinline__ void gemm_phase(PG8_LAS unsigned char* lds, const Gemm g, const Sched& S, const Epi& E) {
    int tid_ = threadIdx.x; asm volatile("" : "+v"(tid_));
    const int tid = tid_, wid = __builtin_amdgcn_readfirstlane(tid >> 6), lane = tid & 63, wr = wid >> 2, wc = wid & 3, fr = lane & 15, fq = lane >> 4;
    const int K = g.K, nt = K / BK;
    unsigned voffA[2], voffB[2];
#pragma unroll
    for (int i = 0; i < 2; ++i) { int R, C; stage_rc(tid * 16 + i * 8192, R, C); const int Rb = Epi::PERM ? ((R & ~31) + perm32(R & 31)) : R;
        voffA[i] = (unsigned)(R * K + C) * 2u; voffB[i] = (unsigned)(Rb * K + C) * 2u; }
    const size_t kstep = (size_t)(BK * 2);
    const size_t hstep = (size_t)HALF * K * 2;
    const size_t tstep = 2 * hstep;
    const unsigned ldsw = (unsigned)wid * 1024u;
    const int aoff = lds_byte(wr * 64 + fr, fq * 8), boff = lds_byte(wc * 32 + fr, fq * 8);
#define PG8_SA(b, h) (((b) * 2 + (h)) * HTB)
#define PG8_SB(b, h) ((4 + (b) * 2 + (h)) * HTB)
#define PG8_STAGE(bufoff, gbase, voff) do { _Pragma("unroll") for (int _i = 0; _i < 2; ++_i) \
        __builtin_amdgcn_global_load_lds((const unsigned*)((const char*)(gbase) + (voff)[_i]), (PG8_LAS unsigned*)(lds + (bufoff) + ldsw + _i * 8192), 16, 0, 0); } while (0)
#define PG8_LDA(dst, b, h) do { _Pragma("unroll") for (int m = 0; m < 4; ++m) _Pragma("unroll") for (int k = 0; k < 2; ++k) dst[m][k] = *(const PG8_LAS bf16x8*)(lds + PG8_SA(b, h) + aoff + m * 2048 + k * 1024); } while (0)
#define PG8_LDB(dst, b, h) do { _Pragma("unroll") for (int n = 0; n < 2; ++n) _Pragma("unroll") for (int k = 0; k < 2; ++k) dst[n][k] = *(const PG8_LAS bf16x8*)(lds + PG8_SB(b, h) + boff + n * 2048 + k * 1024); } while (0)
#define PG8_MMA(ai, bj, At, Bt) do { __builtin_amdgcn_s_setprio(1); _Pragma("unroll") for (int m = 0; m < 4; ++m) _Pragma("unroll") for (int n = 0; n < 2; ++n) _Pragma("unroll") for (int k = 0; k < 2; ++k) \
        acc[ai][bj][m][n] = __builtin_amdgcn_mfma_f32_16x16x32_bf16(Bt[n][k], At[m][k], acc[ai][bj][m][n], 0, 0, 0); __builtin_amdgcn_s_setprio(0); } while (0)
#define PG8_WAIT_V(n) asm volatile("s_waitcnt vmcnt(" #n ")" ::: "memory")
#define PG8_WAIT_L(n) asm volatile("s_waitcnt lgkmcnt(" #n ")" ::: "memory")
#define PG8_BAR __builtin_amdgcn_s_barrier()
#define PG8_SCHED __builtin_amdgcn_sched_barrier(0)
    Unit cur, nxt; int ui = 0;
    if (!S.next(0, cur)) return;
    f32x4 acc[2][2][4][2];
#pragma unroll
    for (int a = 0; a < 2; ++a)
#pragma unroll
        for (int b = 0; b < 2; ++b)
#pragma unroll
            for (int m = 0; m < 4; ++m)
#pragma unroll
                for (int n = 0; n < 2; ++n) acc[a][b][m][n] = (f32x4){0.f, 0.f, 0.f, 0.f};
    bf16x8 At[4][2], B0[2][2], B1[2][2];
    const char* cA = (const char*)g.A + (size_t)cur.pm * tstep; const char* cB = (const char*)g.Bt + (size_t)cur.pn * tstep;
    S.a_ready(cur);
    if constexpr (SP2) {
        PG8_STAGE(PG8_SB(0, 0), cB, voffB); PG8_STAGE(PG8_SB(0, 1), cB + hstep, voffB); PG8_STAGE(PG8_SA(0, 0), cA, voffA); PG8_STAGE(PG8_SA(0, 1), cA + hstep, voffA);
        if (wr == 1) PG8_BAR;
        PG8_WAIT_V(2); PG8_BAR;
        PG8_STAGE(PG8_SB(1, 0), cB + kstep, voffB); PG8_STAGE(PG8_SA(1, 0), cA + kstep, voffA); PG8_STAGE(PG8_SB(1, 1), cB + hstep + kstep, voffB);
        PG8_WAIT_V(6); PG8_BAR;
    } else {
        PG8_STAGE(PG8_SB(0, 0), cB, voffB); PG8_STAGE(PG8_SA(0, 0), cA, voffA); PG8_STAGE(PG8_SB(0, 1), cB + hstep, voffB); PG8_STAGE(PG8_SA(0, 1), cA + hstep, voffA);
        if (wr == 1) PG8_BAR;
        PG8_WAIT_V(4); PG8_BAR;
        PG8_STAGE(PG8_SB(1, 0), cB + kstep, voffB); PG8_STAGE(PG8_SA(1, 0), cA + kstep, voffA); PG8_STAGE(PG8_SB(1, 1), cB + hstep + kstep, voffB);
        PG8_WAIT_V(6); PG8_BAR;
    }
    for (;;) {
        const bool has_next = S.next(ui + 1, nxt);
        const char* nA = has_next ? (const char*)g.A + (size_t)nxt.pm * tstep : cA; const char* nB = has_next ? (const char*)g.Bt + (size_t)nxt.pn * tstep : cB;
        for (int t = 0; t < nt; t += 2) {
            const bool last = (t == nt - 2);
            const char* a1 = cA + (size_t)(t + 1) * kstep;
            const char* a2 = last ? nA : cA + (size_t)(t + 2) * kstep; const char* b2 = last ? nB : cB + (size_t)(t + 2) * kstep;
            const char* a3 = a2 + kstep; const char* b3 = b2 + kstep;
            if (last && has_next) S.a_ready(nxt);
            if constexpr (SP2) {
            PG8_LDB(B0, 0, 0); PG8_LDB(B1, 0, 1); PG8_SCHED; PG8_LDA(At, 0, 0); PG8_STAGE(PG8_SA(1, 1), a1 + hstep, voffA);
            PG8_WAIT_V(8); PG8_WAIT_L(0); PG8_BAR; PG8_MMA(0, 0, At, B0); PG8_MMA(0, 1, At, B1); PG8_BAR; PG8_SCHED;
            PG8_LDA(At, 0, 1); PG8_STAGE(PG8_SB(0, 0), b2, voffB); PG8_STAGE(PG8_SB(0, 1), b2 + hstep, voffB); PG8_STAGE(PG8_SA(0, 0), a2, voffA);
            PG8_WAIT_V(8); PG8_WAIT_L(0); PG8_BAR; PG8_MMA(1, 0, At, B0); PG8_MMA(1, 1, At, B1); PG8_BAR; PG8_SCHED;
            PG8_LDB(B0, 1, 0); PG8_LDB(B1, 1, 1); PG8_SCHED; PG8_LDA(At, 1, 0); PG8_STAGE(PG8_SA(0, 1), a2 + hstep, voffA);
            PG8_WAIT_V(8); PG8_WAIT_L(0); PG8_BAR; PG8_MMA(0, 0, At, B0); PG8_MMA(0, 1, At, B1); PG8_BAR; PG8_SCHED;
            PG8_LDA(At, 1, 1); PG8_STAGE(PG8_SB(1, 0), b3, voffB); PG8_STAGE(PG8_SB(1, 1), b3 + hstep, voffB); PG8_STAGE(PG8_SA(1, 0), a3, voffA);
            PG8_WAIT_V(8); PG8_WAIT_L(0); PG8_BAR; PG8_MMA(1, 0, At, B0); PG8_MMA(1, 1, At, B1); PG8_BAR; PG8_SCHED;
            } else {
            PG8_LDB(B0, 0, 0); PG8_SCHED; PG8_LDA(At, 0, 0); PG8_STAGE(PG8_SA(1, 1), a1 + hstep, voffA);
            PG8_WAIT_L(8); PG8_BAR; PG8_WAIT_L(0); PG8_MMA(0, 0, At, B0); PG8_BAR; PG8_SCHED;
            PG8_LDB(B1, 0, 1); PG8_STAGE(PG8_SB(0, 0), b2, voffB);
            PG8_BAR; PG8_WAIT_L(0); PG8_MMA(0, 1, At, B1); PG8_BAR;
            PG8_LDA(At, 0, 1); PG8_STAGE(PG8_SA(0, 0), a2, voffA);
            PG8_BAR; PG8_WAIT_L(0); PG8_MMA(1, 0, At, B0); PG8_BAR; PG8_SCHED;
            PG8_STAGE(PG8_SB(0, 1), b2 + hstep, voffB);
            PG8_WAIT_V(6); PG8_BAR; PG8_MMA(1, 1, At, B1); PG8_BAR;
            PG8_LDB(B0, 1, 0); PG8_SCHED; PG8_LDA(At, 1, 0); PG8_STAGE(PG8_SA(0, 1), a2 + hstep, voffA);
            PG8_WAIT_L(8); PG8_BAR; PG8_WAIT_L(0); PG8_MMA(0, 0, At, B0); PG8_BAR; PG8_SCHED;
            PG8_LDB(B1, 1, 1); PG8_STAGE(PG8_SB(1, 0), b3, voffB);
            PG8_BAR; PG8_WAIT_L(0); PG8_MMA(0, 1, At, B1); PG8_BAR;
            PG8_LDA(At, 1, 1); PG8_STAGE(PG8_SA(1, 0), a3, voffA);
            PG8_BAR; PG8_WAIT_L(0); PG8_MMA(1, 0, At, B0); PG8_BAR; PG8_SCHED;
            PG8_STAGE(PG8_SB(1, 1), b3 + hstep, voffB);
            PG8_WAIT_V(6); PG8_BAR; PG8_MMA(1, 1, At, B1); PG8_BAR;
            }
        }
        if constexpr (ALIGN_EPI) { if (wr == 0) PG8_BAR; }
        if constexpr (!Epi::AFTER_DRAIN) { E(acc, cur, wr, wc, fr, fq); S.done(cur); }
        if (!has_next) break;
#pragma unroll
        for (int a = 0; a < 2; ++a)
#pragma unroll
            for (int b = 0; b < 2; ++b)
#pragma unroll
                for (int m = 0; m < 4; ++m)
#pragma unroll
                    for (int n = 0; n < 2; ++n) acc[a][b][m][n] = (f32x4){0.f, 0.f, 0.f, 0.f};
        cur = nxt; cA = nA; cB = nB; ++ui;
        if constexpr (ALIGN_EPI) { if (wr == 1) PG8_BAR; }
    }
    PG8_WAIT_V(0);
    if constexpr (!ALIGN_EPI) { if (wr == 0) PG8_BAR; }
    PG8_BAR;
    if constexpr (Epi::AFTER_DRAIN) { E.fused(acc, cur, wr, wc, fr, fq, lds, wid, lane); S.done(cur); }
#undef PG8_SA
#undef PG8_SB
#undef PG8_STAGE
#undef PG8_LDA
#undef PG8_LDB
#undef PG8_MMA
#undef PG8_WAIT_V
#undef PG8_WAIT_L
#undef PG8_BAR
#undef PG8_SCHED
}
}
#include <hip/hip_bf16.h>
#include <cmath>
namespace attn_body {
using bf16=__hip_bfloat16;
using bf16x8=__attribute__((ext_vector_type(8)))short;
using s16x4=__attribute__((ext_vector_type(4)))short;
using f32x16=__attribute__((ext_vector_type(16)))float;
using u32x4=__attribute__((ext_vector_type(4)))unsigned;
constexpr int NW=8;
__device__ __forceinline__ int crow(int r,int hi){return (r&3)+8*(r>>2)+4*hi;}
#define SBAR() __builtin_amdgcn_sched_barrier(0)
constexpr int NSLOT=3, SLOTB=8192;
constexpr int LDS_K=0, LDS_V=NSLOT*SLOTB, LDS_WS=2*NSLOT*SLOTB, LDS_OST=LDS_WS+NW*64*4, LDS_BYTES=LDS_OST+NW*4096;
constexpr float C2=0.125f*1.4426950408889634f;
__device__ __forceinline__ void glds16(const void*gsrc,unsigned lds_dst){unsigned keep;
  asm volatile("s_mov_b32 %0, m0\n\ts_mov_b32 m0, %2\n\ts_nop 0\n\tglobal_load_lds_dwordx4 %1, off\n\ts_mov_b32 m0, %0":"=&s"(keep):"v"(gsrc),"s"(lds_dst):"memory");}
__device__ __forceinline__ float max3f(float a,float b,float c){float r;asm("v_max3_f32 %0, %1, %2, %3":"=v"(r):"v"(a),"v"(b),"v"(c));return r;}
__device__ __forceinline__ float max2f(float a,float b){float r;asm("v_max_f32_e32 %0, %1, %2":"=v"(r):"v"(a),"v"(b));return r;}
__device__ __forceinline__ float fadd_s(float a,float b){float r;asm("v_add_f32_e32 %0, %1, %2":"=v"(r):"v"(a),"v"(b));return r;}
__device__ __forceinline__ float fsub_s(float a,float b){float r;asm("v_sub_f32_e32 %0, %1, %2":"=v"(r):"v"(a),"v"(b));return r;}
typedef float f32x2_t __attribute__((ext_vector_type(2))); typedef __bf16 bf16x2_t __attribute__((ext_vector_type(2)));
__device__ __forceinline__ unsigned cvtpk_s(float lo,float hi){f32x2_t v={lo,hi};bf16x2_t b=__builtin_convertvector(v,bf16x2_t);return __builtin_bit_cast(unsigned,b);}
#define WAIT_BAR(N) asm volatile("s_waitcnt vmcnt(" #N ") lgkmcnt(0)\n\ts_barrier":::"memory")

__device__ __forceinline__ void qkt(f32x16&p0,f32x16&p1,const char*Kslot,const bf16x8*qr,const f32x16&negm,int r32,int hi){
  const char*kb=Kslot+hi*1024+r32*16;
  #pragma unroll
  for(int d0=0;d0<4;++d0){
    const bf16x8 b0=*reinterpret_cast<const bf16x8*>(kb+d0*2048);
    const bf16x8 b1=*reinterpret_cast<const bf16x8*>(kb+d0*2048+512);
    if(d0==0){p0=__builtin_amdgcn_mfma_f32_32x32x16_bf16(b0,qr[0],negm,0,0,0);p1=__builtin_amdgcn_mfma_f32_32x32x16_bf16(b1,qr[0],negm,0,0,0);}
    else{p0=__builtin_amdgcn_mfma_f32_32x32x16_bf16(b0,qr[d0],p0,0,0,0);p1=__builtin_amdgcn_mfma_f32_32x32x16_bf16(b1,qr[d0],p1,0,0,0);}}
}
typedef __attribute__((address_space(3))) const char* lds_cptr;
typedef short v4i16_t __attribute__((ext_vector_type(4)));
__device__ __forceinline__ void kload8(bf16x8*kf,lds_cptr kp){
  kf[0]=*(const __attribute__((address_space(3))) bf16x8*)(kp);      kf[1]=*(const __attribute__((address_space(3))) bf16x8*)(kp+512);
  kf[2]=*(const __attribute__((address_space(3))) bf16x8*)(kp+2048); kf[3]=*(const __attribute__((address_space(3))) bf16x8*)(kp+2560);
  kf[4]=*(const __attribute__((address_space(3))) bf16x8*)(kp+4096); kf[5]=*(const __attribute__((address_space(3))) bf16x8*)(kp+4608);
  kf[6]=*(const __attribute__((address_space(3))) bf16x8*)(kp+6144); kf[7]=*(const __attribute__((address_space(3))) bf16x8*)(kp+6656);
}
__device__ __forceinline__ void kload2(bf16x8*kf,lds_cptr kp,int j){ kf[2*j]=*(const __attribute__((address_space(3))) bf16x8*)(kp+j*2048); kf[2*j+1]=*(const __attribute__((address_space(3))) bf16x8*)(kp+j*2048+512); }
__device__ __forceinline__ s16x4 vtr(lds_cptr p){ return __builtin_bit_cast(s16x4,__builtin_amdgcn_ds_read_tr16_b64_v4i16((__attribute__((address_space(3))) v4i16_t*)p)); }
__device__ __forceinline__ float rowmax(const f32x16&p0,const f32x16&p1){
  float a=max3f(p0[0],p0[1],p1[0]),b=max3f(p0[2],p0[3],p1[1]);a=max3f(a,p1[2],p1[3]);
  #pragma unroll
  for(int r=4;r<16;r+=4){a=max3f(a,p0[r],p0[r+1]);b=max3f(b,p0[r+2],p0[r+3]);a=max3f(a,p1[r],p1[r+1]);b=max3f(b,p1[r+2],p1[r+3]);}
  const float m=max2f(a,b);
  auto rr=__builtin_amdgcn_permlane32_swap(__float_as_uint(m),__float_as_uint(m),false,false);
  return max2f(__uint_as_float(rr[0]),__uint_as_float(rr[1]));
}
__device__ __forceinline__ void pv(f32x16*o,int vb,bf16x8 pa0,bf16x8 pa1,bf16x8 pa2,bf16x8 pa3){
  #pragma unroll
  for(int d0=0;d0<2;++d0){s16x4 lo[4],hi[4];
    #pragma unroll
    for(int ks=0;ks<4;++ks){
      asm volatile("ds_read_b64_tr_b16 %0,%1 offset:%c2":"=&v"(lo[ks]):"v"(vb),"i"(d0*4096+ks*1024):"memory");
      asm volatile("ds_read_b64_tr_b16 %0,%1 offset:%c2":"=&v"(hi[ks]):"v"(vb),"i"(d0*4096+ks*1024+512):"memory");}
    asm volatile("s_waitcnt lgkmcnt(0)":::"memory");SBAR();
    #define PK(k) (bf16x8){lo[k][0],lo[k][1],lo[k][2],lo[k][3],hi[k][0],hi[k][1],hi[k][2],hi[k][3]}
    o[d0]=__builtin_amdgcn_mfma_f32_32x32x16_bf16(pa0,PK(0),o[d0],0,0,0);
    o[d0]=__builtin_amdgcn_mfma_f32_32x32x16_bf16(pa1,PK(1),o[d0],0,0,0);
    o[d0]=__builtin_amdgcn_mfma_f32_32x32x16_bf16(pa2,PK(2),o[d0],0,0,0);
    o[d0]=__builtin_amdgcn_mfma_f32_32x32x16_bf16(pa3,PK(3),o[d0],0,0,0);
    #undef PK
  }
}

struct AUnit { const bf16* Q; const bf16* K; const bf16* V; bf16* O; float* lse; int opitch, NT, nreal, dsh, qe0, ke0, cls0, split, band; };
constexpr int PITCH = 3072;
#ifndef ATTN_STORE16
#define ATTN_STORE16(p,v) (*(u32x4*)(p)=(v))
#endif
template<int THRL> __device__ __forceinline__ void attn_unit(const AUnit&U,char*shm){
  const int tid=threadIdx.x,lane=tid&63,r32=lane&31,hi=lane>>5; const int wid=__builtin_amdgcn_readfirstlane(tid>>6);
  const int dsh=U.dsh,split=U.split,nreal=U.nreal,NT=U.NT,band=U.band,ke0=U.ke0,cls0=U.cls0;
  const int wsub=split?(wid&3):wid, qcls=cls0+(split?(wid>>2):0);
  const int qew=U.qe0+32*wsub;
  const int qe=qew+r32;
  const unsigned lds0=(unsigned)(uintptr_t)shm;
  float*wsf=(float*)(shm+LDS_WS)+wid*64;
  #define TT(t) (((t)<nreal)?(t):(nreal-1))
  #define TE0(tt) (ke0+64*(split?((tt)&1):(tt)))
  #define TCL(tt) (cls0+(split?((tt)>>1):0))
  const bf16*kcol=U.K+wid*8;
  const bf16*vcol=U.V+(wid>>2)*32+(lane&3)*8;
  const int vrow=16*(wid&3)+(lane>>2);
  const unsigned kdst=lds0+LDS_K+wid*1024, vdst=lds0+LDS_V+wid*1024;
  #define DMA_K(t,slot) do{ const int tt_=TT(t); glds16(kcol+(long)(((TE0(tt_)+lane)<<dsh)+TCL(tt_))*PITCH,(unsigned)__builtin_amdgcn_readfirstlane(kdst+(slot))); }while(0)
  #define DMA_V(t,slot) do{ const int tt_=TT(t); glds16(vcol+(long)(((TE0(tt_)+vrow)<<dsh)+TCL(tt_))*PITCH,(unsigned)__builtin_amdgcn_readfirstlane(vdst+(slot))); }while(0)
  const int vb0=(int)(lds0+LDS_V)+((lane>>4)&1)*32+(lane&3)*8+(4*hi+((lane&15)>>2))*64;
  const char*Kbase=shm+LDS_K; bf16x8 kf[8];
  const lds_cptr shm3=(lds_cptr)shm; const lds_cptr kp0=shm3+LDS_K+hi*1024+r32*16; const lds_cptr vp0=shm3+LDS_V+((lane>>4)&1)*32+(lane&3)*8+(4*hi+((lane&15)>>2))*64;
  DMA_K(0,0);DMA_V(0,0);DMA_K(1,SLOTB);
  bf16x8 qr[4];
  { const bf16*Qw=U.Q+(long)((qe<<dsh)+qcls)*PITCH+hi*8;
  #pragma unroll
  for(int d0=0;d0<4;++d0)qr[d0]=*reinterpret_cast<const bf16x8*>(Qw+d0*16); }
  float mhat=0.f,l_reg=0.f;f32x16 o[2];o[0]=f32x16{};o[1]=f32x16{};f32x16 negm=f32x16{};asm volatile("":"+v"(negm));
  #define BMASK(P0,P1,t) do{ if(band){ const int tt_=TT(t); int lo_=qe-64-TE0(tt_)-4*hi, hh_=qe+64-TE0(tt_)-4*hi; if(TCL(tt_)!=qcls||(t)>=nreal)lo_=4096; \
    _Pragma("unroll") for(int r=0;r<16;++r){ const int c_=(r&3)+8*(r>>2); if(c_<lo_||c_>hh_)P0[r]=-INFINITY; if(c_+32<lo_||c_+32>hh_)P1[r]=-INFINITY; } } }while(0)
  bool resc=false;
  #define START(P0,P1) do{ const float rm=rowmax(P0,P1); resc=false; \
    { const float dl=(rm==-INFINITY)?0.f:rm; mhat=fadd_s(mhat,dl); \
      _Pragma("unroll") for(int r=0;r<16;++r){P0[r]=fsub_s(P0[r],dl);P1[r]=fsub_s(P1[r],dl);} \
      _Pragma("unroll") for(int r=0;r<16;++r)negm[r]=-mhat; asm volatile("":"+v"(negm)); } \
    _Pragma("unroll") for(int r=0;r<16;++r)P0[r]=__builtin_amdgcn_exp2f(P0[r]); }while(0)
  #define RESC() do{ if(resc){ asm volatile("s_waitcnt lgkmcnt(0)":::"memory"); \
      _Pragma("unroll") for(int d_=0;d_<2;++d_) _Pragma("unroll") for(int r=0;r<16;++r)o[d_][r]*=wsf[crow(r,hi)]; } }while(0)
  f32x16 pA0,pA1,pB0,pB1;
  int sl_prev=0,sl_cur=0,sl_next=SLOTB;
  #define ROT() do{sl_prev=sl_cur;sl_cur=sl_next;sl_next=(sl_next==(NSLOT-1)*SLOTB)?0:sl_next+SLOTB;}while(0)
  DMA_K(2,2*SLOTB);
  WAIT_BAR(3);
  qkt(pA0,pA1,Kbase,qr,negm,r32,hi);asm volatile("s_nop 15\n\ts_nop 7":"+v"(pA0),"+v"(pA1));BMASK(pA0,pA1,0);
  START(pA0,pA1);
  _Pragma("unroll") for(int r=0;r<16;++r)pA1[r]=__builtin_amdgcn_exp2f(pA1[r]);
  WAIT_BAR(0);
  DMA_K(3,0);DMA_V(1,SLOTB);
  ROT();
  kload8(kf,kp0+sl_cur);
  WAIT_BAR(2);
  s16x4 vlo[8],vhi[8]; u32x4 pw0,pw1,pw2,pw3;
  #define PKW(P,B) cvtpk_s(P[B],P[B+1])
  #define PAF(k) __builtin_bit_cast(bf16x8,pw##k)
  #define VFR(i) (bf16x8){vlo[i][0],vlo[i][1],vlo[i][2],vlo[i][3],vhi[i][0],vhi[i][1],vhi[i][2],vhi[i][3]}
  #define PIN(x) asm volatile("":"+v"(x))
  #define MX3(a,b,c) __builtin_fmaxf(__builtin_fmaxf((a),(b)),(c))
  #define GAPA(MF,A0,A1,A2,A3,W0,W1,PW) do{ MF; sacc+=A0; sacc+=A1; sacc+=A2; sacc+=A3; PIN(sacc); W0; W1; PIN(PW); SBAR(); }while(0)
  #define EX(v) __builtin_amdgcn_exp2f(v)
  #define GAPB(MF,X,B) do{ MF; X[B]=EX(X[B]); X[B+1]=EX(X[B+1]); X[B+2]=EX(X[B+2]); X[B+3]=EX(X[B+3]); PIN(X); SBAR(); }while(0)
  #define VRD(i) do{ vlo[i]=vtr(vp_+(((i)>>2)*4096+((i)&3)*1024)); vhi[i]=vtr(vp_+(((i)>>2)*4096+((i)&3)*1024+512)); }while(0)
  #define KRD(G,j) do{ if(G){ kload2(kf,kp0+sl_next,j); SBAR(); } }while(0)
  #define STEP(C0,C1,P0,P1,t,GK,GV,GL) do{ SBAR(); \
    const lds_cptr vp_=vp0+sl_prev; \
    VRD(0); SBAR(); float sacc=(P0[0]+P0[1]); \
    GAPA(C0=__builtin_amdgcn_mfma_f32_32x32x16_bf16(kf[0],qr[0],negm,0,0,0), P0[2],P0[3],P0[4],P0[5],     pw0[0]=PKW(P0,0), pw0[1]=PKW(P0,2), pw0); \
    VRD(4); SBAR(); GAPA(C1=__builtin_amdgcn_mfma_f32_32x32x16_bf16(kf[1],qr[0],negm,0,0,0), P0[6],P0[7],P0[8],P0[9],     pw0[2]=PKW(P0,4), pw0[3]=PKW(P0,6), pw0); \
    VRD(1); SBAR(); GAPA(C0=__builtin_amdgcn_mfma_f32_32x32x16_bf16(kf[2],qr[1],C0,0,0,0),   P0[10],P0[11],P0[12],P0[13], pw1[0]=PKW(P0,8), pw1[1]=PKW(P0,10), pw1); \
    VRD(5); SBAR(); GAPA(C1=__builtin_amdgcn_mfma_f32_32x32x16_bf16(kf[3],qr[1],C1,0,0,0),   P0[14],P0[15],P1[0],P1[1],   pw1[2]=PKW(P0,12),pw1[3]=PKW(P0,14), pw1); \
    VRD(2); SBAR(); GAPA(C0=__builtin_amdgcn_mfma_f32_32x32x16_bf16(kf[4],qr[2],C0,0,0,0),   P1[2],P1[3],P1[4],P1[5],     pw2[0]=PKW(P1,0), pw2[1]=PKW(P1,2), pw2); \
    VRD(6); SBAR(); GAPA(C1=__builtin_amdgcn_mfma_f32_32x32x16_bf16(kf[5],qr[2],C1,0,0,0),   P1[6],P1[7],P1[8],P1[9],     pw2[2]=PKW(P1,4), pw2[3]=PKW(P1,6), pw2); \
    VRD(3); SBAR(); GAPA(C0=__builtin_amdgcn_mfma_f32_32x32x16_bf16(kf[6],qr[3],C0,0,0,0),   P1[10],P1[11],P1[12],P1[13], pw3[0]=PKW(P1,8), pw3[1]=PKW(P1,10), pw3); \
    VRD(7); SBAR(); GAPA(C1=__builtin_amdgcn_mfma_f32_32x32x16_bf16(kf[7],qr[3],C1,0,0,0),   P1[14],P1[15],0.f,0.f,       pw3[2]=PKW(P1,12),pw3[3]=PKW(P1,14), pw3); \
    l_reg+=sacc; \
    if(GK){DMA_K((t)+3,sl_cur);} if(GV){DMA_V((t)+1,sl_next);} \
    CMASK(C0,C1,t); \
    { float a=MX3(C0[0],C0[1],C1[0]),b=MX3(C0[2],C0[3],C1[1]); a=MX3(a,C1[2],C1[3]); \
      _Pragma("unroll") for(int r=4;r<16;r+=4){a=MX3(a,C0[r],C0[r+1]);b=MX3(b,C0[r+2],C0[r+3]);a=MX3(a,C1[r],C1[r+1]);b=MX3(b,C1[r+2],C1[r+3]);} \
      float rm=__builtin_fmaxf(a,b); { auto rr=__builtin_amdgcn_permlane32_swap(__float_as_uint(rm),__float_as_uint(rm),false,false); rm=__builtin_fmaxf(__uint_as_float(rr[0]),__uint_as_float(rr[1])); } \
      resc=false; \
      if(__builtin_expect(__any(rm>(float)THRL),0)){ const float dl=__builtin_fmaxf(rm,0.f); mhat+=dl; \
        _Pragma("unroll") for(int r=0;r<16;++r){C0[r]-=dl;C1[r]-=dl;} \
        _Pragma("unroll") for(int r=0;r<16;++r)negm[r]=-mhat; asm volatile("":"+v"(negm)); \
        const float f=__builtin_amdgcn_exp2f(-dl); l_reg*=f; if(hi==0)wsf[r32]=f; resc=true; } } \
    SBAR(); \
    GAPB(o[0]=__builtin_amdgcn_mfma_f32_32x32x16_bf16(PAF(0),VFR(0),o[0],0,0,0), C0,0); \
    GAPB(o[1]=__builtin_amdgcn_mfma_f32_32x32x16_bf16(PAF(0),VFR(4),o[1],0,0,0), C0,4); \
    KRD(GL,0); GAPB(o[0]=__builtin_amdgcn_mfma_f32_32x32x16_bf16(PAF(1),VFR(1),o[0],0,0,0), C0,8); \
    KRD(GL,1); GAPB(o[1]=__builtin_amdgcn_mfma_f32_32x32x16_bf16(PAF(1),VFR(5),o[1],0,0,0), C0,12); \
    KRD(GL,2); GAPB(o[0]=__builtin_amdgcn_mfma_f32_32x32x16_bf16(PAF(2),VFR(2),o[0],0,0,0), C1,0); \
    KRD(GL,3); GAPB(o[1]=__builtin_amdgcn_mfma_f32_32x32x16_bf16(PAF(2),VFR(6),o[1],0,0,0), C1,4); \
    GAPB(o[0]=__builtin_amdgcn_mfma_f32_32x32x16_bf16(PAF(3),VFR(3),o[0],0,0,0), C1,8); \
    GAPB(o[1]=__builtin_amdgcn_mfma_f32_32x32x16_bf16(PAF(3),VFR(7),o[1],0,0,0), C1,12); \
    }while(0)
  int t=1;
  #define CMASK(P0,P1,t) do{}while(0)
  for(;t+5<NT;t+=2){
    STEP(pB0,pB1,pA0,pA1,t,true,true,true);     WAIT_BAR(2); RESC(); ROT();
    STEP(pA0,pA1,pB0,pB1,t+1,true,true,true);   WAIT_BAR(2); RESC(); ROT();
  }
  #undef CMASK
  #define CMASK(P0,P1,t) BMASK(P0,P1,t)
  #define ENDW(tt) do{ if((tt)+3<NT){WAIT_BAR(2);} else if((tt)+2<NT){WAIT_BAR(1);} else {WAIT_BAR(0);} }while(0)
  for(;t+1<NT;t+=2){
    STEP(pB0,pB1,pA0,pA1,t,(t+3<NT),(t+1<NT),(t+1<NT));       ENDW(t);   RESC(); ROT();
    STEP(pA0,pA1,pB0,pB1,t+1,(t+4<NT),(t+2<NT),(t+2<NT));     ENDW(t+1); RESC(); ROT();
  }
  STEP(pB0,pB1,pA0,pA1,NT-1,false,false,false); RESC();
  { float sacc=pB0[0]+pB0[1]; _Pragma("unroll") for(int r=2;r<16;++r)sacc+=pB0[r]; _Pragma("unroll") for(int r=0;r<16;++r)sacc+=pB1[r]; l_reg+=sacc;
    pw0=(u32x4){PKW(pB0,0),PKW(pB0,2),PKW(pB0,4),PKW(pB0,6)};pw1=(u32x4){PKW(pB0,8),PKW(pB0,10),PKW(pB0,12),PKW(pB0,14)};pw2=(u32x4){PKW(pB1,0),PKW(pB1,2),PKW(pB1,4),PKW(pB1,6)};pw3=(u32x4){PKW(pB1,8),PKW(pB1,10),PKW(pB1,12),PKW(pB1,14)};
    SBAR(); pv(o,vb0+sl_cur,PAF(0),PAF(1),PAF(2),PAF(3)); }
  #undef PKW
  #undef PAF
  #undef VFR
  #undef PIN
  #undef MX3
  #undef GAPA
  #undef GAPB
  #undef EX
  #undef VRD
  #undef KRD
  #undef STEP
  #undef ENDW
  #undef CMASK
  {auto rr=__builtin_amdgcn_permlane32_swap(__float_as_uint(l_reg),__float_as_uint(l_reg),false,false);l_reg=__uint_as_float(rr[0])+__uint_as_float(rr[1]);}
  if(hi==0)wsf[32+r32]=l_reg;asm volatile("s_waitcnt lgkmcnt(0)":::"memory");
  if(U.lse!=nullptr&&hi==0)U.lse[(long)((qe<<dsh)+qcls)*8]=mhat+__log2f(l_reg);
  float rli[16];
  #pragma unroll
  for(int r=0;r<16;++r)rli[r]=__builtin_amdgcn_rcpf(wsf[32+crow(r,hi)]);
  { bf16*stg=(bf16*)(shm+LDS_OST)+wid*2048;
    #pragma unroll
    for(int r=0;r<16;++r){const int orow=crow(r,hi);
      #pragma unroll
      for(int d0=0;d0<2;++d0)stg[orow*64+d0*32+r32]=__float2bfloat16(o[d0][r]*rli[r]);}
    asm volatile("s_waitcnt lgkmcnt(0)":::"memory");
    #pragma unroll
    for(int i=0;i<4;++i){const int row=i*8+(lane>>3),ch=lane&7; const u32x4 v=*(const u32x4*)(stg+row*64+ch*8); ATTN_STORE16(U.O+(long)(((qew+row)<<dsh)+qcls)*U.opitch+ch*8,v);} }
  asm volatile("s_waitcnt lgkmcnt(0)\n\ts_barrier":::"memory");
  #undef DMA_K
  #undef DMA_V
  #undef BMASK
  #undef START
  #undef RESC
  #undef ROT
  #undef TT
  #undef TE0
  #undef TCL
}
constexpr int ATTN_LDS_BYTES=LDS_BYTES;
#undef SBAR
#undef WAIT_BAR
}

constexpr int NWAVES = 8;
constexpr int BATCH = 8, SEQ = 2048, D = 1024, FF = 4096, DIN = 3072, DPLE = 256;
constexpr int M = BATCH * SEQ;
constexpr float NORM_EPS = 1e-6f, SUBLN_EPS = 1e-5f, LAM_INIT = 0.2f;

constexpr size_t MiB = 1u << 20;
constexpr size_t WS_CTL = 0, CTL_ZERO_BYTES = 1 * MiB;
constexpr size_t WS_ROPE = 1 * MiB;
constexpr size_t WS_WIN = 2 * MiB, WS_WOUT = 8 * MiB, WS_WUP = 10 * MiB, WS_WDN = 18 * MiB, WS_WGT = 26 * MiB, WS_WPP = 28 * MiB;
constexpr size_t WS_SSQ1 = 29 * MiB, WS_SSQ2 = 30 * MiB, WS_SSQ3 = 31 * MiB;
constexpr size_t WS_XN = 32 * MiB;
constexpr size_t WS_QKV = 64 * MiB;
constexpr size_t WS_MIX = 160 * MiB;
constexpr size_t WS_U = 64 * MiB;
constexpr size_t WS_PP = 64 * MiB;
constexpr size_t WS_PB = 192 * MiB;
constexpr size_t WS_OD1 = 200 * MiB, WS_OD2 = 216 * MiB;
constexpr size_t WS_END = 256 * MiB;
constexpr size_t OUT_ODIL = 0, OUT_LSE = 48 * MiB;
constexpr int CW_BAR = 4096;

constexpr int RING_OFF = 0, RING_BYTES = 131072;
constexpr int LDSCTL_OFF = RING_BYTES, MISC_OFF = LDSCTL_OFF + 320;
constexpr int LDS_BYTES = 147456;
static_assert(MISC_OFF + 128 <= LDS_BYTES, "LDS map");
#define GAS __attribute__((address_space(1)))
#define LAS __attribute__((address_space(3)))
typedef unsigned short bf16;
typedef unsigned v4u __attribute__((ext_vector_type(4)));
typedef float f32x4 __attribute__((ext_vector_type(4)));
typedef short bf16x8 __attribute__((ext_vector_type(8)));
typedef GAS unsigned gu32;
typedef GAS unsigned long long gu64;
#define RLX_AGENT __ATOMIC_RELAXED, __HIP_MEMORY_SCOPE_AGENT
#define LDS_WAIT() asm volatile("s_waitcnt lgkmcnt(0)" ::: "memory")
#define VM_WAIT() asm volatile("s_waitcnt vmcnt(0)" ::: "memory")
__device__ __forceinline__ unsigned long long rt() { return __builtin_amdgcn_s_memrealtime(); }
__device__ __forceinline__ unsigned f2bf(float f) { unsigned u = __builtin_bit_cast(unsigned, f); return (u + 0x7fffu + ((u >> 16) & 1u)) >> 16; }
__device__ __forceinline__ unsigned pk2(float lo, float hi) { return f2bf(lo) | (f2bf(hi) << 16); }

#define XB_TMO      128
#define XB_XCNT(j)  (256  + 64 * (j))
#define XB_XSUB(j)  (1280 + 64 * (j))
#define XB_XGEN(j)  (2304 + 64 * (j))
#define XB_TOP      3328
#define XB_TOPGEN   3392
#define XCD_BAR_WORDS 3456
#define XB_SPIN_CAP (1u << 18)

__device__ __forceinline__ unsigned xb_ld(unsigned* p)              { return __hip_atomic_load(p, __ATOMIC_RELAXED, __HIP_MEMORY_SCOPE_AGENT); }
__device__ __forceinline__ unsigned xb_add(unsigned* p, unsigned v) { return __hip_atomic_fetch_add(p, v, __ATOMIC_RELAXED, __HIP_MEMORY_SCOPE_AGENT); }
__device__ __forceinline__ unsigned xb_xcc_id() { return (unsigned)__builtin_amdgcn_s_getreg((3 << 11) | 20) & 0xFu; }
#define XB_SPIN(cond, bar) do { unsigned _sp = 0; while (cond) { __builtin_amdgcn_s_sleep(1); \
    if ((++_sp & 255u) == 0u) { if (xb_ld(&(bar)[XB_TMO])) break; if (_sp > XB_SPIN_CAP) { atomicAdd(&(bar)[XB_TMO], 1u); break; } } } } while (0)

struct XcdBarrier {
    unsigned* bar; unsigned x;
    volatile LAS unsigned* st;
};

__device__ __forceinline__ XcdBarrier xcd_barrier_post(unsigned* bar, volatile LAS unsigned* st) {
    XcdBarrier b; b.bar = bar; b.x = xb_xcc_id(); b.st = st;
    if (threadIdx.x == 0) (void)xb_add(&bar[XB_XCNT(b.x)], 1u);
    return b;
}
__device__ __forceinline__ void xcd_barrier_complete(unsigned* bar, unsigned x, unsigned& nloc, unsigned& nx) {
    const unsigned G = gridDim.x * gridDim.y * gridDim.z;
    unsigned sum, cnt, mine, sp = 0u;
    for (;;) {
        sum = 0u; cnt = 0u; mine = 0u;
#pragma unroll
        for (unsigned j = 0; j < 16; ++j) { const unsigned c = xb_ld(&bar[XB_XCNT(j)]); sum += c; cnt += (c > 0u) ? 1u : 0u; mine = (j == x) ? c : mine; }
        if (sum == G) break;
        __builtin_amdgcn_s_sleep(1);
        if ((++sp & 255u) == 0u) { if (xb_ld(&bar[XB_TMO])) break; if (sp > XB_SPIN_CAP) { atomicAdd(&bar[XB_TMO], 1u); break; } }
    }
    nloc = mine > 0u ? mine : 1u; nx = cnt > 0u ? cnt : 1u;
}

__device__ __forceinline__ void xcd_barrier(const XcdBarrier& b) {
    asm volatile("s_waitcnt vmcnt(0)" ::: "memory");
    __syncthreads();
    if (threadIdx.x == 0) {
        unsigned* bar = b.bar;
        __builtin_amdgcn_s_waitcnt(0);
        unsigned nloc = b.st[0], nx = b.st[1];
        if (nloc == 0u) { xcd_barrier_complete(bar, b.x, nloc, nx); b.st[0] = nloc; b.st[1] = nx; }
        const unsigned old = xb_add(&bar[XB_XSUB(b.x)], 1u);
        const unsigned gen = old / nloc;
        if (old + 1u == (gen + 1u) * nloc) {
            __builtin_amdgcn_fence(__ATOMIC_RELEASE, "agent");
            asm volatile("s_waitcnt vmcnt(0)" ::: "memory");
            const unsigned og = xb_add(&bar[XB_TOP], 1u);
            const unsigned tg = og / nx;
            if (og + 1u == (tg + 1u) * nx) xb_add(&bar[XB_TOPGEN], 1u);
            else XB_SPIN(xb_ld(&bar[XB_TOPGEN]) == tg, bar);
            __builtin_amdgcn_fence(__ATOMIC_ACQUIRE, "agent");
            xb_add(&bar[XB_XGEN(b.x)], 1u);
            asm volatile("s_waitcnt vmcnt(0)" ::: "memory");
        } else {
            XB_SPIN(xb_ld(&bar[XB_XGEN(b.x)]) == gen, bar);
            __builtin_amdgcn_fence(__ATOMIC_ACQUIRE, "agent");
            asm volatile("s_waitcnt vmcnt(0)" ::: "memory");
        }
    }
    __syncthreads();
}

struct Frame {
    LAS unsigned char* lds;
    volatile LAS unsigned* MISC;
    gu32* ctl;
    int tid, lane, wave;
    int vcu, G;
};

__device__ __forceinline__ float wave_sum(float v) {
#pragma unroll
    for (int o = 1; o < 64; o <<= 1) v += __shfl_xor(v, o);
    return v;
}
__device__ __forceinline__ int win_row(int n) {
    const int type = n >> 9; if (type == 2 || type == 5) return n;
    const int j = n & 63; return (n - j) + 8 * ((j & 31) >> 2) + 4 * (j >> 5) + (j & 3);
}
template <bool ROWMAP>
__device__ __forceinline__ void p0_transpose_item(const float* W, int K, int N, bf16* WT, const float* kscale, LAS float* scr, int item, int lane) {
    const int nblk = N / 32, kb = item / nblk, nb = item % nblk, k0 = 64 * kb, n0 = 32 * nb;
#pragma unroll 8
    for (int i = 0; i < 32; ++i) { const int kk = 2 * i + (lane >> 5); const float g = kscale ? kscale[k0 + kk] : 1.f; scr[kk * 33 + (lane & 31)] = W[(size_t)(k0 + kk) * N + n0 + (lane & 31)] * g; }
    LDS_WAIT(); asm volatile("" ::: "memory");
    const int c = lane & 7;
#pragma unroll
    for (int j = 0; j < 4; ++j) { const int n = (lane >> 3) + 8 * j; const LAS float* s = scr + (8 * c) * 33 + n;
        v4u o; o.x = pk2(s[0 * 33], s[1 * 33]); o.y = pk2(s[2 * 33], s[3 * 33]); o.z = pk2(s[4 * 33], s[5 * 33]); o.w = pk2(s[6 * 33], s[7 * 33]);
        const int orow = ROWMAP ? win_row(n0 + n) : (n0 + n);
        *(GAS v4u*)(WT + (size_t)orow * K + k0 + 8 * c) = o; }
    LDS_WAIT(); asm volatile("" ::: "memory");
}
__device__ __forceinline__ void rms_row_to_bf16(int lane, const float* xrow, const float* g, bf16* orow) {
    const GAS f32x4* xr = (const GAS f32x4*)xrow + lane;
    f32x4 v[4]; float s = 0.f;
#pragma unroll
    for (int j = 0; j < 4; ++j) { v[j] = xr[64 * j]; s += (v[j].x * v[j].x + v[j].y * v[j].y) + (v[j].z * v[j].z + v[j].w * v[j].w); }
    const float rstd = 1.f / sqrtf(wave_sum(s) * (1.f / D) + NORM_EPS);
    GAS unsigned long long* o8 = (GAS unsigned long long*)orow + lane;
#pragma unroll
    for (int j = 0; j < 4; ++j) { const f32x4 gg = ((const GAS f32x4*)g)[lane + 64 * j];
        o8[64 * j] = (unsigned long long)pk2(v[j].x * rstd * gg.x, v[j].y * rstd * gg.y) | ((unsigned long long)pk2(v[j].z * rstd * gg.z, v[j].w * rstd * gg.w) << 32); }
}

__device__ const double INV_FREQ[32] = {
    1.00000000000000000000e+00, 7.49894209332455874417e-01, 5.62341325190349072827e-01, 4.21696503428582225581e-01,
    3.16227766016837941176e-01, 2.37137370566165517349e-01, 1.77827941003892292526e-01, 1.33352143216332402753e-01,
    1.00000000000000005551e-01, 7.49894209332455791150e-02, 5.62341325190349114460e-02, 4.21696503428582239459e-02,
    3.16227766016837913421e-02, 2.37137370566165538166e-02, 1.77827941003892292526e-02, 1.33352143216332406223e-02,
    1.00000000000000002082e-02, 7.49894209332455791150e-03, 5.62341325190349097113e-03, 4.21696503428582291501e-03,
    3.16227766016837939442e-03, 2.37137370566165538166e-03, 1.77827941003892275179e-03, 1.33352143216332406223e-03,
    1.00000000000000002082e-03, 7.49894209332455856203e-04, 5.62341325190349097113e-04, 4.21696503428582237290e-04,
    3.16227766016837939442e-04, 2.37137370566165538166e-04, 1.77827941003892269758e-04, 1.33352143216332395381e-04};
__device__ __forceinline__ void rope_cs(int s, int j, float& c, float& sn) {
    const double ang = (double)s * INV_FREQ[j];
    double rev = ang * 0.15915494309189533577;
    rev -= floor(rev);
    const double q = rint(rev * 4.0);
    const double y = (rev - q * 0.25) * 6.28318530717958647692;
    const double y2 = y * y;
    const double sy = y * (1.0 + y2 * (-1.0 / 6 + y2 * (1.0 / 120 + y2 * (-1.0 / 5040 + y2 * (1.0 / 362880 + y2 * (-1.0 / 39916800 + y2 * (1.0 / 6227020800.0)))))));
    const double cy = 1.0 + y2 * (-0.5 + y2 * (1.0 / 24 + y2 * (-1.0 / 720 + y2 * (1.0 / 40320 + y2 * (-1.0 / 3628800 + y2 * (1.0 / 479001600 + y2 * (-1.0 / 87178291200.0)))))));
    const int qi = ((int)q) & 3;
    double cc, ss;
    if (qi == 0) { cc = cy; ss = sy; } else if (qi == 1) { cc = -sy; ss = cy; } else if (qi == 2) { cc = -cy; ss = -sy; } else { cc = sy; ss = -cy; }
    c = (float)cc; sn = (float)ss;
}

struct Args { const float* in[17]; float* out; unsigned char* ws; int ph_lo, ph_hi; };
__global__ void __launch_bounds__(NWAVES * 64, 2) mega_fwd(Args args) {
    extern __shared__ __attribute__((aligned(16))) unsigned char lds[];
    Frame F;
    F.lds = (LAS unsigned char*)lds;
    F.MISC = (volatile LAS unsigned*)(F.lds + MISC_OFF);
    F.tid = threadIdx.x; F.lane = F.tid & 63; F.wave = __builtin_amdgcn_readfirstlane(F.tid >> 6);
    F.G = gridDim.x; { const int bx = blockIdx.x; F.vcu = (F.G % 8 == 0) ? (bx % 8) * (F.G / 8) + bx / 8 : bx; }
    unsigned char* ws = args.ws;
    F.ctl = (gu32*)(ws + WS_CTL);
    const float* x = args.in[0]; const float* p_in = args.in[1]; const float* w_in = args.in[2]; const float* w_out = args.in[3]; const float* g_mix = args.in[4];
    const float* lq1 = args.in[5]; const float* lk1 = args.in[6]; const float* lq2 = args.in[7]; const float* lk2 = args.in[8]; const float* g_subln = args.in[9];
    const float* g_mlp = args.in[10]; const float* w_up = args.in[11]; const float* w_down = args.in[12]; const float* g_ple = args.in[13];
    const float* w_gate = args.in[14]; const float* w_pp = args.in[15]; const float* g_final = args.in[16];
    float* out = args.out;
    bf16* Win_t = (bf16*)(ws + WS_WIN); bf16* Wout_t = (bf16*)(ws + WS_WOUT); bf16* Wup_t = (bf16*)(ws + WS_WUP); bf16* Wdn_t = (bf16*)(ws + WS_WDN);
    bf16* Wgt_t = (bf16*)(ws + WS_WGT); bf16* Wpp_t = (bf16*)(ws + WS_WPP);
    bf16* XN = (bf16*)(ws + WS_XN); bf16* QKV = (bf16*)(ws + WS_QKV); bf16* MIX = (bf16*)(ws + WS_MIX); bf16* UB = (bf16*)(ws + WS_U); bf16* PP = (bf16*)(ws + WS_PP);
    bf16* PB = (bf16*)(ws + WS_PB); bf16* OD1 = (bf16*)(ws + WS_OD1); bf16* OD2 = (bf16*)(ws + WS_OD2);
    bf16* ODIL = (bf16*)((unsigned char*)out + OUT_ODIL); float* LSE = (float*)((unsigned char*)out + OUT_LSE);
    float* SSQ1 = (float*)(ws + WS_SSQ1); float* SSQ2 = (float*)(ws + WS_SSQ2); float* SSQ3 = (float*)(ws + WS_SSQ3);
    float* ROPE = (float*)(ws + WS_ROPE);

    for (int u = F.tid; u < (LDS_BYTES - LDSCTL_OFF) / 4; u += NWAVES * 64) ((LAS unsigned*)(F.lds + LDSCTL_OFF))[u] = 0u;
    __syncthreads();
    XcdBarrier bar = xcd_barrier_post((unsigned*)(F.ctl + CW_BAR), F.MISC + 8);
    const int lo = args.ph_lo, hi = args.ph_hi;
#define IN(k) (lo <= (k) && (k) < hi)
#define BOTH(k) (IN(k) && IN((k) + 1))
#define GRID_BAR() xcd_barrier(bar)
    const int gw = F.vcu * NWAVES + F.wave, NGW = F.G * NWAVES;

    if (IN(0)) {
        LAS float* scr = (LAS float*)(F.lds + RING_OFF + F.wave * 16384);
        constexpr int I_IN = (D / 64) * (DIN / 32), I_OUT = (D / 64) * (D / 32), I_UP = (D / 64) * (FF / 32), I_DN = (FF / 64) * (D / 32), I_GT = I_OUT, I_PP = (DPLE / 64) * (D / 32);
        constexpr int NITEMS = I_IN + I_OUT + I_UP + I_DN + I_GT + I_PP;
        for (int it = gw; it < NITEMS; it += NGW) {
            int r = it;
            if (r < I_IN) { p0_transpose_item<true>(w_in, D, DIN, Win_t, nullptr, scr, r, F.lane); continue; } r -= I_IN;
            if (r < I_OUT) { p0_transpose_item<false>(w_out, D, D, Wout_t, nullptr, scr, r, F.lane); continue; } r -= I_OUT;
            if (r < I_UP) { p0_transpose_item<false>(w_up, D, FF, Wup_t, g_mlp, scr, r, F.lane); continue; } r -= I_UP;
            if (r < I_DN) { p0_transpose_item<false>(w_down, FF, D, Wdn_t, nullptr, scr, r, F.lane); continue; } r -= I_DN;
            if (r < I_GT) { p0_transpose_item<false>(w_gate, D, D, Wgt_t, g_ple, scr, r, F.lane); continue; } r -= I_GT;
            p0_transpose_item<false>(w_pp, DPLE, D, Wpp_t, nullptr, scr, r, F.lane);
        }
        { const int gt = (F.vcu * NWAVES + F.wave) * 64 + F.lane; const int NT_ = F.G * NWAVES * 64;
          for (int i = gt; i < SEQ * 32; i += NT_) { float c, s; rope_cs(i >> 5, i & 31, c, s); ROPE[2 * i] = c; ROPE[2 * i + 1] = s; } }
        for (int m = gw; m < M; m += NGW) {
            rms_row_to_bf16(F.lane, x + (size_t)m * D, g_mix, XN + (size_t)m * D);
            const f32x4 pv = ((const GAS f32x4*)(p_in + (size_t)m * DPLE))[F.lane];
            ((GAS unsigned long long*)(PB + (size_t)m * DPLE))[F.lane] = (unsigned long long)pk2(pv.x, pv.y) | ((unsigned long long)pk2(pv.z, pv.w) << 32);
        }
        if (BOTH(0)) GRID_BAR();
    }

    if (IN(1)) {
        pg8::Gemm g{XN, Win_t, M, DIN, D}; pg8::StaticOrder S; S.init(M, DIN, F.G, (int)blockIdx.x);
        pg8::EpiQKV E{QKV, ROPE, attn_body::C2};
        pg8::gemm_phase<pg8::EpiQKV, pg8::StaticOrder, true, true>(F.lds + RING_OFF, g, S, E);
        if (BOTH(1)) GRID_BAR();
    }

    if (IN(2)) {
        const int b = F.vcu >> 5, cu = F.vcu & 31;
        const attn_body::bf16* Qb = (const attn_body::bf16*)QKV + (size_t)b * SEQ * 3072;
        for (int i = 0; i < 10; ++i) {
            attn_body::AUnit U;
            if (i < 4) {
                const int uid = 4 * cu + i, vh = uid >> 3, qb = uid & 7, h = vh >> 2, map = (vh >> 1) & 1, vhalf = vh & 1;
                U.Q = Qb + h * 128 + map * 64; U.K = Qb + 512 + h * 128 + map * 64; U.V = Qb + 1024 + h * 128 + vhalf * 64;
                U.O = (attn_body::bf16*)(map ? OD2 : OD1) + (size_t)b * SEQ * 512 + h * 128 + vhalf * 64; U.lse = nullptr; U.opitch = 512;
                U.NT = 32; U.nreal = 32; U.dsh = 0; U.qe0 = 256 * qb; U.ke0 = 0; U.cls0 = 0; U.split = 0; U.band = 0;
            } else {
                const int uid = 6 * cu + (i - 4), head = uid / 24, idx = uid % 24, pat = idx >> 3, c = idx & 7;
                U.Q = Qb + 1536 + head * 64; U.K = Qb + 2048 + head * 64; U.V = Qb + 2560 + head * 64;
                U.O = (attn_body::bf16*)ODIL + (size_t)pat * M * 512 + (size_t)b * SEQ * 512 + head * 64; U.opitch = 512;
                U.lse = LSE + (size_t)pat * M * 8 + (size_t)b * SEQ * 8 + head; U.band = 1;
                if (pat == 0) { const int first = (4 * c - 1 < 0) ? 0 : 4 * c - 1, last = (4 * c + 4 > 31) ? 31 : 4 * c + 4;
                    U.dsh = 0; U.cls0 = 0; U.split = 0; U.qe0 = 256 * c; U.ke0 = 64 * first; U.nreal = last - first + 1; }
                else if (pat == 1) { const int cc = c & 1, first = cc ? 3 : 0;
                    U.dsh = 2; U.cls0 = c >> 1; U.split = 0; U.qe0 = 256 * cc; U.ke0 = 64 * first; U.nreal = 5; }
                else { U.dsh = 4; U.cls0 = 2 * c; U.split = 1; U.qe0 = 0; U.ke0 = 0; U.nreal = 4; }
                U.NT = U.nreal + (U.nreal & 1);
            }
            attn_body::attn_unit<8>(U, (char*)lds + RING_OFF);
        }
        if (BOTH(2)) GRID_BAR();
    }

    if (IN(3)) {
        const float a1 = wave_sum(lq1[F.lane] * lk1[F.lane]), a2 = wave_sum(lq2[F.lane] * lk2[F.lane]);
        const float lam = expf(a1) - expf(a2) + LAM_INIT;
        f32x4 gs0 = *(const GAS f32x4*)(g_subln + (8 * F.lane) % 128), gs1 = *(const GAS f32x4*)(g_subln + (8 * F.lane) % 128 + 4);
        gs0 = gs0 * (1.0f - LAM_INIT); gs1 = gs1 * (1.0f - LAM_INIT);
        for (int m = gw; m < M; m += NGW) {
            const v4u w1 = *(const GAS v4u*)(OD1 + (size_t)m * 512 + 8 * F.lane), w2 = *(const GAS v4u*)(OD2 + (size_t)m * 512 + 8 * F.lane);
            float v[8];
#define UNPK(w, i) ((i) & 1 ? __uint_as_float((w) & 0xffff0000u) : __uint_as_float((w) << 16))
            v[0] = UNPK(w1.x, 0) - lam * UNPK(w2.x, 0); v[1] = UNPK(w1.x, 1) - lam * UNPK(w2.x, 1); v[2] = UNPK(w1.y, 0) - lam * UNPK(w2.y, 0); v[3] = UNPK(w1.y, 1) - lam * UNPK(w2.y, 1);
            v[4] = UNPK(w1.z, 0) - lam * UNPK(w2.z, 0); v[5] = UNPK(w1.z, 1) - lam * UNPK(w2.z, 1); v[6] = UNPK(w1.w, 0) - lam * UNPK(w2.w, 0); v[7] = UNPK(w1.w, 1) - lam * UNPK(w2.w, 1);
            float sq = ((v[0] * v[0] + v[1] * v[1]) + (v[2] * v[2] + v[3] * v[3])) + ((v[4] * v[4] + v[5] * v[5]) + (v[6] * v[6] + v[7] * v[7]));
            sq += __shfl_xor(sq, 1); sq += __shfl_xor(sq, 2); sq += __shfl_xor(sq, 4); sq += __shfl_xor(sq, 8);
            const float rinv = 1.0f / sqrtf(sq * (1.0f / 128.0f) + SUBLN_EPS);
            v4u o; o.x = pk2(v[0] * rinv * gs0.x, v[1] * rinv * gs0.y); o.y = pk2(v[2] * rinv * gs0.z, v[3] * rinv * gs0.w);
            o.z = pk2(v[4] * rinv * gs1.x, v[5] * rinv * gs1.y); o.w = pk2(v[6] * rinv * gs1.z, v[7] * rinv * gs1.w);
            *(GAS v4u*)(MIX + (size_t)m * D + 8 * F.lane) = o;
            const int hd = F.lane >> 3;
            const float l0 = LSE[(size_t)m * 8 + hd], l1 = LSE[(size_t)M * 8 + (size_t)m * 8 + hd], l2 = LSE[(size_t)2 * M * 8 + (size_t)m * 8 + hd];
            const float mm = fmaxf(l0, fmaxf(l1, l2));
            float e0 = __builtin_amdgcn_exp2f(l0 - mm), e1 = __builtin_amdgcn_exp2f(l1 - mm), e2 = __builtin_amdgcn_exp2f(l2 - mm);
            const float rs = 1.0f / (e0 + e1 + e2); e0 *= rs; e1 *= rs; e2 *= rs;
            const v4u d0 = *(const GAS v4u*)(ODIL + (size_t)m * 512 + 8 * F.lane), d1 = *(const GAS v4u*)(ODIL + (size_t)M * 512 + (size_t)m * 512 + 8 * F.lane),
                      d2 = *(const GAS v4u*)(ODIL + (size_t)2 * M * 512 + (size_t)m * 512 + 8 * F.lane);
            v4u q;
            q.x = pk2(e0 * UNPK(d0.x, 0) + e1 * UNPK(d1.x, 0) + e2 * UNPK(d2.x, 0), e0 * UNPK(d0.x, 1) + e1 * UNPK(d1.x, 1) + e2 * UNPK(d2.x, 1));
            q.y = pk2(e0 * UNPK(d0.y, 0) + e1 * UNPK(d1.y, 0) + e2 * UNPK(d2.y, 0), e0 * UNPK(d0.y, 1) + e1 * UNPK(d1.y, 1) + e2 * UNPK(d2.y, 1));
            q.z = pk2(e0 * UNPK(d0.z, 0) + e1 * UNPK(d1.z, 0) + e2 * UNPK(d2.z, 0), e0 * UNPK(d0.z, 1) + e1 * UNPK(d1.z, 1) + e2 * UNPK(d2.z, 1));
            q.w = pk2(e0 * UNPK(d0.w, 0) + e1 * UNPK(d1.w, 0) + e2 * UNPK(d2.w, 0), e0 * UNPK(d0.w, 1) + e1 * UNPK(d1.w, 1) + e2 * UNPK(d2.w, 1));
            *(GAS v4u*)(MIX + (size_t)m * D + 512 + 8 * F.lane) = q;
#undef UNPK
        }
        if (BOTH(3)) GRID_BAR();
    }

    if (IN(4)) {
        pg8::Gemm g{MIX, Wout_t, M, D, D}; pg8::StaticOrder S; S.init(M, D, F.G, (int)blockIdx.x);
        pg8::EpiRes E{x, out, XN, SSQ1};
        pg8::gemm_phase<pg8::EpiRes, pg8::StaticOrder, true, true>(F.lds + RING_OFF, g, S, E);
        if (BOTH(4)) GRID_BAR();
    }

    if (IN(5)) {
        pg8::Gemm g{XN, Wup_t, M, FF, D}; pg8::StaticOrder S; S.init(M, FF, F.G, (int)blockIdx.x);
        pg8::EpiUp E{UB, SSQ1, NORM_EPS};
        pg8::gemm_phase<pg8::EpiUp, pg8::StaticOrder, true, true>(F.lds + RING_OFF, g, S, E);
        if (BOTH(5)) GRID_BAR();
    }

    if (IN(6)) {
        pg8::Gemm g{UB, Wdn_t, M, D, FF}; pg8::StaticOrder S; S.init(M, D, F.G, (int)blockIdx.x);
        pg8::EpiRes E{out, out, XN, SSQ2};
        pg8::gemm_phase<pg8::EpiRes, pg8::StaticOrder, true, true>(F.lds + RING_OFF, g, S, E);
        if (BOTH(6)) GRID_BAR();
    }

    if (IN(7)) {
        { pg8::Gemm g{PB, Wpp_t, M, D, DPLE}; pg8::StaticOrder S; S.init(M, D, F.G, (int)blockIdx.x);
          pg8::EpiStore E{PP};
          pg8::gemm_phase<pg8::EpiStore, pg8::StaticOrder, true, true>(F.lds + RING_OFF, g, S, E); }
        VM_WAIT(); __syncthreads();
        { pg8::Gemm g{XN, Wgt_t, M, D, D}; pg8::StaticOrder S; S.init(M, D, F.G, (int)blockIdx.x);
          pg8::EpiGate E{out, out, PP, SSQ2, SSQ3, NORM_EPS};
          pg8::gemm_phase<pg8::EpiGate, pg8::StaticOrder, true, true>(F.lds + RING_OFF, g, S, E); }
        if (BOTH(7)) GRID_BAR();
    }

    if (IN(8)) {
        for (int m = gw; m < M; m += NGW) {
            GAS f32x4* xr = (GAS f32x4*)(out + (size_t)m * D) + F.lane;
            const float rinv = 1.0f / sqrtf(pg8::ssq16(SSQ3 + (size_t)m * 16) * (1.f / D) + NORM_EPS);
#pragma unroll
            for (int j = 0; j < 4; ++j) { const f32x4 gg = ((const GAS f32x4*)g_final)[F.lane + 64 * j]; f32x4 v = xr[64 * j]; v = v * rinv * gg; xr[64 * j] = v; }
        }
    }
#undef IN
#undef BOTH
#undef GRID_BAR
}

extern "C" void kernel_launch(void* const* d_in, const int* in_sizes, int n_in, void* d_out, int out_size, void* d_ws, size_t ws_size, hipStream_t stream) {
    static int grid = 0;
    if (grid == 0) {
        if (n_in != 17 || in_sizes[0] != M * D || out_size != M * D || ws_size < WS_END) { fprintf(stderr, "kernel_launch: unexpected problem shape; nothing launched\n"); grid = -1; return; }
        int dev = 0, cus = 0, per_cu = 0;
        if (hipGetDevice(&dev) != hipSuccess || hipDeviceGetAttribute(&cus, hipDeviceAttributeMultiprocessorCount, dev) != hipSuccess) { grid = -1; return; }
        if (hipFuncSetAttribute((const void*)mega_fwd, hipFuncAttributeMaxDynamicSharedMemorySize, LDS_BYTES) != hipSuccess) { fprintf(stderr, "kernel_launch: hipFuncSetAttribute failed\n"); grid = -1; return; }
        if (hipOccupancyMaxActiveBlocksPerMultiprocessor(&per_cu, (const void*)mega_fwd, NWAVES * 64, LDS_BYTES) != hipSuccess || per_cu < 1)
            fprintf(stderr, "kernel_launch: note: occupancy query reports %d workgroups per CU\n", per_cu);
        (void)hipGetLastError();
        grid = cus;
        if (grid != 256) fprintf(stderr, "kernel_launch: %d CUs; this kernel's static schedules assume 256\n", grid);
    }
    if (grid < 0) return;
    if (hipMemsetAsync((char*)d_ws + WS_CTL, 0, CTL_ZERO_BYTES, stream) != hipSuccess) return;
    Args a{};
    for (int i = 0; i < 17; ++i) a.in[i] = (const float*)d_in[i];
    a.out = (float*)d_out; a.ws = (unsigned char*)d_ws; a.ph_lo = 0; a.ph_hi = 9;
    hipLaunchKernelGGL(mega_fwd, dim3(grid), dim3(NWAVES * 64), LDS_BYTES, stream, a);
}
```
